# Optimizing an MI355X kernel written in HIP

```python
import jax, jax.numpy as jnp
from jax import lax
import numpy as np

D_MODEL = 1024
BATCH = 8
SEQ = 4096
DEPTH = 1

HEAD_DIM = 64
ROPE_THETA = 10000.0
RMS_EPS = 1e-6
NEG_BIG = -1e30

SWA_HEADS = 8
SWA_KV_HEADS = 2
SWA_WINDOW = 128
SWA_BLOCK = 128

NSA_HEADS = 8
NSA_KV_HEADS = 2
CMP_LEN = 32
CMP_STRIDE = 16
CMP_HIDDEN = 256
SEL_BLOCK = 64
SEL_TOPN = 16
SEL_QCHUNK = 64
NSA_WINDOW = 512
NSA_BLOCK = 128
NSA_N_GATES = 3

KV_W = HEAD_DIM * SWA_KV_HEADS
NKV_W = HEAD_DIM * NSA_KV_HEADS
SPLIT_SIZES = (
    SWA_HEADS * HEAD_DIM, KV_W, KV_W,
    NSA_HEADS * HEAD_DIM,
    NKV_W, NKV_W, NKV_W, NKV_W, NKV_W, NKV_W,
    NSA_HEADS * NSA_N_GATES,
)
IN_WIDTH = sum(SPLIT_SIZES)
MIX_WIDTH = (SWA_HEADS + NSA_HEADS) * HEAD_DIM

PEER_HEADS = 8
N_KEYS = 128
N_EXPERTS = N_KEYS * N_KEYS
PEER_QDIM = 256
PEER_TOPK = 16
PEER_CHUNK = 128

kernel_name = "hymba_swa_sink_nsa_peer_block"


def rmsnorm(x, g):
    xf = x.astype(jnp.float32)
    y = xf * lax.rsqrt(jnp.mean(xf * xf, axis=-1, keepdims=True) + RMS_EPS)
    return (y * g.astype(jnp.float32)).astype(x.dtype)


def rope(x, positions):
    half = HEAD_DIM // 2
    inv_freq = ROPE_THETA ** (-jnp.arange(half, dtype=jnp.float32) / half)
    ang = positions.astype(jnp.float32)[..., None] * inv_freq
    cos = jnp.cos(ang)[:, :, None, :]
    sin = jnp.sin(ang)[:, :, None, :]
    xf = x.astype(jnp.float32)
    x1, x2 = xf[..., :half], xf[..., half:]
    return jnp.concatenate([x1 * cos - x2 * sin, x2 * cos + x1 * sin], axis=-1).astype(x.dtype)


def banded_gqa_attention(q, k, v, window, block, sinks=None):
    B, T, H, dh = q.shape
    Hkv = k.shape[2]
    G = H // Hkv
    nb = T // block
    nprev = -(-(window - 1) // block)
    span = (nprev + 1) * block
    pad = ((0, 0), (nprev * block, 0), (0, 0), (0, 0))
    kp = jnp.pad(k, pad)
    vp = jnp.pad(v, pad)
    kidx = (jnp.arange(nb) * block)[:, None] + jnp.arange(span)[None, :]
    kb = kp[:, kidx]
    vb = vp[:, kidx]
    qb = q.reshape(B, nb, block, Hkv, G, dh)
    s = jnp.einsum('bnqhgd,bnkhd->bnhgqk', qb, kb).astype(jnp.float32) * (dh ** -0.5)
    qpos = (jnp.arange(nb) * block)[:, None] + jnp.arange(block)[None, :]
    kpos = kidx - nprev * block
    diff = qpos[:, :, None] - kpos[:, None, :]
    mask = (diff >= 0) & (diff < window) & (kpos[:, None, :] >= 0)
    s = jnp.where(mask[None, :, None, None], s, -jnp.inf)
    if sinks is None:
        p = jax.nn.softmax(s, axis=-1)
    else:
        sink = sinks.astype(jnp.float32).reshape(Hkv, G)[None, None, :, :, None, None]
        sink = jnp.broadcast_to(sink, s.shape[:-1] + (1,))
        p = jax.nn.softmax(jnp.concatenate([s, sink], axis=-1), axis=-1)[..., :-1]
    o = jnp.einsum('bnhgqk,bnkhd->bnqhgd', p.astype(v.dtype), vb)
    return o.reshape(B, T, H, dh)


def compress_blocks(kv, pos_emb, w1, w2):
    B, T, Hkv, dh = kv.shape
    nc = (T - CMP_LEN) // CMP_STRIDE + 1
    idx = (jnp.arange(nc) * CMP_STRIDE)[:, None] + jnp.arange(CMP_LEN)[None, :]
    blocks = kv[:, idx] + pos_emb[None, None, :, None, :]
    flat = blocks.transpose(0, 1, 3, 2, 4).reshape(B, nc, Hkv, CMP_LEN * dh)
    return jax.nn.gelu(flat @ w1, approximate=False) @ w2


def nsa_compressed_attention(q5, k_cmp, v_cmp):
    T = q5.shape[1]
    nc = k_cmp.shape[1]
    s = jnp.einsum('bthgd,bchd->bhgtc', q5, k_cmp).astype(jnp.float32) * (HEAD_DIM ** -0.5)
    vis = (jnp.arange(nc) * CMP_STRIDE + CMP_LEN - 1)[None, :] <= jnp.arange(T)[:, None]
    p = jnp.where(vis, jax.nn.softmax(jnp.where(vis, s, NEG_BIG), axis=-1), 0.0)
    o = jnp.einsum('bhgtc,bchd->bthgd', p.astype(v_cmp.dtype), v_cmp)
    return o, p


def nsa_select_blocks(p_cmp, T):
    nc = p_cmp.shape[-1]
    ns = T // SEL_BLOCK
    n_sel = min(SEL_TOPN, ns)
    cstart = jnp.arange(nc) * CMP_STRIDE
    bstart = jnp.arange(ns) * SEL_BLOCK
    lo = jnp.maximum(cstart[:, None], bstart[None, :])
    hi = jnp.minimum(cstart[:, None] + CMP_LEN, bstart[None, :] + SEL_BLOCK)
    overlap = jnp.clip(hi - lo, 0).astype(jnp.float32) / CMP_LEN
    imp = jnp.einsum('bhgtc,cj->bhtj', p_cmp, overlap)
    t = jnp.arange(T)[:, None]
    j = jnp.arange(ns)[None, :]
    cur = t // SEL_BLOCK
    valid = j * SEL_BLOCK <= t
    forced = (j == 0) | (j == cur) | (j == cur - 1)
    score = jnp.where(forced, jnp.inf, jnp.where(valid, imp, -jnp.inf))
    top, idx = lax.top_k(score, n_sel)
    return idx, top > -jnp.inf


def nsa_selected_attention(q5, k_sel, v_sel, sel_idx, sel_valid):
    B, T, Hkv, G, dh = q5.shape
    ns = T // SEL_BLOCK
    n_sel = sel_idx.shape[-1]
    C = SEL_QCHUNK
    nq = T // C
    kb = k_sel.reshape(B, ns, SEL_BLOCK, Hkv, dh).transpose(0, 3, 1, 2, 4)
    vb = v_sel.reshape(B, ns, SEL_BLOCK, Hkv, dh).transpose(0, 3, 1, 2, 4)
    qc = q5.reshape(B, nq, C, Hkv, G, dh).transpose(1, 0, 3, 4, 2, 5)
    ic = sel_idx.reshape(B, Hkv, nq, C, n_sel).transpose(2, 0, 1, 3, 4)
    vc = sel_valid.reshape(B, Hkv, nq, C, n_sel).transpose(2, 0, 1, 3, 4)
    t0 = jnp.arange(nq) * C
    bi = jnp.arange(B)[:, None, None, None]
    hi = jnp.arange(Hkv)[None, :, None, None]

    def step(args):
        q_c, i_c, v_c, start = args
        kg = kb[bi, hi, i_c]
        vg = vb[bi, hi, i_c]
        s = jnp.einsum('bhgqd,bhqnkd->bhgqnk', q_c, kg).astype(jnp.float32) * (dh ** -0.5)
        kpos = i_c[..., None] * SEL_BLOCK + jnp.arange(SEL_BLOCK)
        qpos = start + jnp.arange(C)
        mask = (kpos <= qpos[None, None, :, None, None]) & v_c[..., None]
        s = jnp.where(mask[:, :, None], s, -jnp.inf)
        p = jax.nn.softmax(s.reshape(B, Hkv, G, C, n_sel * SEL_BLOCK), axis=-1)
        p = p.reshape(B, Hkv, G, C, n_sel, SEL_BLOCK)
        return jnp.einsum('bhgqnk,bhqnkd->bqhgd', p.astype(vg.dtype), vg)

    out = lax.map(step, (qc, ic, vc, t0))
    return out.transpose(1, 0, 2, 3, 4, 5).reshape(B, T, Hkv, G, dh)


def peer_ffn(h, w_query, sub_keys_1, sub_keys_2, expert_down, expert_up):
    B, T, D = h.shape
    N = B * T
    ht = h.reshape(N, D)
    q = (ht @ w_query).reshape(N, PEER_HEADS, 2, PEER_QDIM // 2)
    s1 = jnp.einsum('nhd,kd->nhk', q[:, :, 0], sub_keys_1)
    s2 = jnp.einsum('nhd,kd->nhk', q[:, :, 1], sub_keys_2)
    t1, i1 = lax.top_k(s1, PEER_TOPK)
    t2, i2 = lax.top_k(s2, PEER_TOPK)
    cand = (t1[..., :, None] + t2[..., None, :]).reshape(N, PEER_HEADS, PEER_TOPK * PEER_TOPK)
    cidx = (i1[..., :, None] * N_KEYS + i2[..., None, :]).reshape(N, PEER_HEADS, PEER_TOPK * PEER_TOPK)
    sc, pos = lax.top_k(cand, PEER_TOPK)
    eidx = jnp.take_along_axis(cidx, pos, axis=-1)
    gate = jax.nn.softmax(sc.astype(jnp.float32), axis=-1).astype(h.dtype)
    nchunk = N // PEER_CHUNK

    def step(args):
        x_c, e_c, g_c = args
        u = expert_down[e_c]
        a = jax.nn.gelu(jnp.einsum('cd,chkd->chk', x_c, u), approximate=False)
        vv = expert_up[e_c]
        return jnp.einsum('chk,chkd->cd', g_c * a, vv)

    out = lax.map(step, (ht.reshape(nchunk, PEER_CHUNK, D),
                         eidx.reshape(nchunk, PEER_CHUNK, PEER_HEADS, PEER_TOPK),
                         gate.reshape(nchunk, PEER_CHUNK, PEER_HEADS, PEER_TOPK)))
    return out.reshape(B, T, D)


def hybrid_layer(x, positions, norm_attn, w_in, attn_sinks,
                 cmp_k_pos, cmp_k_w1, cmp_k_w2, cmp_v_pos, cmp_v_w1, cmp_v_w2,
                 w_out, norm_ffn, peer_w_query, peer_sub_keys_1, peer_sub_keys_2,
                 peer_expert_down, peer_expert_up):
    B, T, _ = x.shape
    h = rmsnorm(x, norm_attn)
    proj = h @ w_in
    offsets = np.cumsum(SPLIT_SIZES)[:-1].tolist()
    qa, ka, va, qb, kc, vc, ks, vs, kw, vw, gl = jnp.split(proj, offsets, axis=-1)
    hd = lambda t, n: t.reshape(B, T, n, HEAD_DIM)

    qa = rope(hd(qa, SWA_HEADS), positions)
    ka = rope(hd(ka, SWA_KV_HEADS), positions)
    o_a = banded_gqa_attention(qa, ka, hd(va, SWA_KV_HEADS), SWA_WINDOW, SWA_BLOCK, attn_sinks)

    G = NSA_HEADS // NSA_KV_HEADS
    qb = rope(hd(qb, NSA_HEADS), positions)
    q5 = qb.reshape(B, T, NSA_KV_HEADS, G, HEAD_DIM)
    k_cmp = compress_blocks(rope(hd(kc, NSA_KV_HEADS), positions), cmp_k_pos, cmp_k_w1, cmp_k_w2)
    v_cmp = compress_blocks(hd(vc, NSA_KV_HEADS), cmp_v_pos, cmp_v_w1, cmp_v_w2)
    o_cmp, p_cmp = nsa_compressed_attention(q5, k_cmp, v_cmp)
    sel_idx, sel_valid = nsa_select_blocks(p_cmp, T)
    o_sel = nsa_selected_attention(q5, rope(hd(ks, NSA_KV_HEADS), positions),
                                   hd(vs, NSA_KV_HEADS), sel_idx, sel_valid)
    o_win = banded_gqa_attention(qb, rope(hd(kw, NSA_KV_HEADS), positions),
                                 hd(vw, NSA_KV_HEADS), NSA_WINDOW, NSA_BLOCK)
    gates = jax.nn.sigmoid(gl.astype(jnp.float32)).astype(x.dtype).reshape(B, T, NSA_HEADS, NSA_N_GATES)
    o_b = (gates[..., 0:1] * o_cmp.reshape(B, T, NSA_HEADS, HEAD_DIM)
           + gates[..., 1:2] * o_sel.reshape(B, T, NSA_HEADS, HEAD_DIM)
           + gates[..., 2:3] * o_win)

    mixed = jnp.concatenate([o_a.reshape(B, T, -1), o_b.reshape(B, T, -1)], axis=-1)
    x = x + mixed @ w_out
    x = x + peer_ffn(rmsnorm(x, norm_ffn), peer_w_query, peer_sub_keys_1, peer_sub_keys_2,
                     peer_expert_down, peer_expert_up)
    return x


def setup_inputs(seed: int = 0) -> dict:
    key = jax.random.key(seed)
    ks = jax.random.split(key, 20)
    f32 = jnp.float32
    nrm = lambda k, shape, scale: jax.random.normal(k, shape, f32) * scale
    L = DEPTH
    return {
        "x": nrm(ks[0], (BATCH, SEQ, D_MODEL), 1.0),
        "positions": jnp.broadcast_to(jnp.arange(SEQ, dtype=jnp.int32)[None, :], (BATCH, SEQ)),
        "norm_attn": 1.0 + nrm(ks[1], (L, D_MODEL), 0.02),
        "w_in": nrm(ks[2], (L, D_MODEL, IN_WIDTH), D_MODEL ** -0.5),
        "attn_sinks": nrm(ks[3], (L, SWA_HEADS), 0.5),
        "cmp_k_pos": nrm(ks[4], (L, CMP_LEN, HEAD_DIM), 0.1),
        "cmp_k_w1": nrm(ks[5], (L, CMP_LEN * HEAD_DIM, CMP_HIDDEN), (CMP_LEN * HEAD_DIM) ** -0.5),
        "cmp_k_w2": nrm(ks[6], (L, CMP_HIDDEN, HEAD_DIM), CMP_HIDDEN ** -0.5),
        "cmp_v_pos": nrm(ks[7], (L, CMP_LEN, HEAD_DIM), 0.1),
        "cmp_v_w1": nrm(ks[8], (L, CMP_LEN * HEAD_DIM, CMP_HIDDEN), (CMP_LEN * HEAD_DIM) ** -0.5),
        "cmp_v_w2": nrm(ks[9], (L, CMP_HIDDEN, HEAD_DIM), CMP_HIDDEN ** -0.5),
        "w_out": nrm(ks[10], (L, MIX_WIDTH, D_MODEL), MIX_WIDTH ** -0.5),
        "norm_ffn": 1.0 + nrm(ks[11], (L, D_MODEL), 0.02),
        "peer_w_query": nrm(ks[12], (L, D_MODEL, PEER_HEADS * PEER_QDIM), D_MODEL ** -0.5),
        "peer_sub_keys_1": nrm(ks[13], (L, N_KEYS, PEER_QDIM // 2), (PEER_QDIM // 2) ** -0.5),
        "peer_sub_keys_2": nrm(ks[14], (L, N_KEYS, PEER_QDIM // 2), (PEER_QDIM // 2) ** -0.5),
        "peer_expert_down": nrm(ks[15], (L, N_EXPERTS, D_MODEL), D_MODEL ** -0.5),
        "peer_expert_up": nrm(ks[16], (L, N_EXPERTS, D_MODEL), 0.5),
        "norm_f": 1.0 + nrm(ks[17], (D_MODEL,), 0.02),
    }


def reference(x, positions, norm_attn, w_in, attn_sinks, cmp_k_pos, cmp_k_w1, cmp_k_w2,
              cmp_v_pos, cmp_v_w1, cmp_v_w2, w_out, norm_ffn, peer_w_query,
              peer_sub_keys_1, peer_sub_keys_2, peer_expert_down, peer_expert_up, norm_f):
    h = x
    for layer in range(DEPTH):
        h = hybrid_layer(h, positions, norm_attn[layer], w_in[layer], attn_sinks[layer],
                         cmp_k_pos[layer], cmp_k_w1[layer], cmp_k_w2[layer],
                         cmp_v_pos[layer], cmp_v_w1[layer], cmp_v_w2[layer],
                         w_out[layer], norm_ffn[layer], peer_w_query[layer],
                         peer_sub_keys_1[layer], peer_sub_keys_2[layer],
                         peer_expert_down[layer], peer_expert_up[layer])
    return rmsnorm(h, norm_f)
```

```cpp
#include <hip/hip_runtime.h>
#include <cstdio>
#include <cstdint>

#ifndef MK_N_LAUNCHES
#define MK_N_LAUNCHES 1
#endif

#define LAS __attribute__((address_space(3)))
typedef unsigned short bf16;
typedef short bf16x8 __attribute__((ext_vector_type(8)));
typedef short bf16x4 __attribute__((ext_vector_type(4)));
typedef float f32x4 __attribute__((ext_vector_type(4)));
typedef unsigned u32x4 __attribute__((ext_vector_type(4)));
typedef unsigned u32x2 __attribute__((ext_vector_type(2)));

constexpr int NB = 8, T = 4096, D = 1024, NTOK = NB * T, HD = 64;
constexpr int INW = 2072, INW_PAD = 2176;
constexpr int NPHASE = 12;
constexpr float RMS_EPS = 1e-6f;

constexpr size_t MiB = 1u << 20;
constexpr size_t WS_CTL = 0, CTL_BYTES = 64 * 1024;
constexpr size_t WS_WIN_T = 2 * MiB;
constexpr size_t WS_WG_T = 6 * MiB;
constexpr size_t WS_WOUT_T = 8 * MiB;
constexpr size_t WS_WQ_T = 10 * MiB;
constexpr size_t WS_CW1_T = 14 * MiB;
constexpr size_t WS_CW2_T = 16 * MiB;
constexpr size_t WS_CB1 = 16 * MiB + 256 * 1024;
constexpr size_t WS_SUBK = 16 * MiB + 512 * 1024;
constexpr size_t WS_ROPE_C = 18 * MiB, WS_ROPE_S = 22 * MiB;
constexpr size_t WS_GATES = 26 * MiB;
constexpr size_t WS_CHID = 30 * MiB;
constexpr size_t WS_KCMP = 34 * MiB;
constexpr size_t WS_VCMP = 34 * MiB + 512 * 1024;
constexpr size_t WS_EDOWN = 36 * MiB, WS_EUP = 52 * MiB;
constexpr size_t WS_ESD = 68 * MiB, WS_ESU = 68 * MiB + 64 * 1024;
constexpr size_t WS_H = 100 * MiB;
constexpr size_t WS_MIXED = 164 * MiB;
constexpr size_t WS_Q = 228 * MiB;
constexpr size_t WS_KV = 292 * MiB;
constexpr size_t WS_PEERQ = 228 * MiB;
constexpr size_t WS_EIDX = 356 * MiB;
constexpr size_t WS_EGATE = 372 * MiB;
constexpr size_t WS_SSP = 420 * MiB;
constexpr size_t WS_ESDT = 422 * MiB;
constexpr size_t WS_H2S = 438 * MiB;
constexpr size_t WS_CSC = 438 * MiB + 256 * 1024;
constexpr size_t WS_COEFQ = 388 * MiB;
constexpr size_t WS_SS2 = 439 * MiB;
constexpr size_t WS_H2Q = 388 * MiB;
constexpr size_t WS_PPART = 228 * MiB;
constexpr size_t WS_AMP = 440 * MiB;
constexpr size_t WS_R2 = 442 * MiB;
constexpr size_t WS_AMAX = 442 * MiB + 256 * 1024;
constexpr size_t WS_GMAX = 442 * MiB + 512 * 1024;
constexpr size_t WS_END = 443 * MiB;
constexpr int CW_RANK = 8192;
constexpr size_t KV_TENSOR = (size_t)NB * 2 * T * 64;

constexpr int LDS_BYTES = 147456;
constexpr int LDS_BARW = LDS_BYTES - 16;
constexpr int LDS_JOB = LDS_BYTES - 48;

__device__ __forceinline__ float bf2f(unsigned v) { return __uint_as_float(v << 16); }
__device__ __forceinline__ unsigned f2bf(float f) { unsigned u = __float_as_uint(f); return (u + 0x7fffu + ((u >> 16) & 1u)) >> 16; }
__device__ __forceinline__ unsigned pk2(float lo, float hi) { unsigned r; asm("v_cvt_pk_bf16_f32 %0, %1, %2" : "=v"(r) : "v"(lo), "v"(hi)); return r; }
__device__ __forceinline__ float wave_sum(float v) {
#pragma unroll
    for (int o = 1; o < 64; o <<= 1) v += __shfl_xor(v, o);
    return v;
}
__device__ __forceinline__ float gelu_erf(float v) { return 0.5f * v * (1.0f + erff(v * 0.70710678118654752f)); }

#define XB_TMO      128
#define XB_XCNT(j)  (256  + 64 * (j))
#define XB_XSUB(j)  (1280 + 64 * (j))
#define XB_XGEN(j)  (2304 + 64 * (j))
#define XB_TOP      3328
#define XB_TOPGEN   3392
#define XCD_BAR_WORDS 3456
#define XB_SPIN_CAP (1u << 18)

__device__ __forceinline__ unsigned xb_ld(unsigned* p)              { return __hip_atomic_load(p, __ATOMIC_RELAXED, __HIP_MEMORY_SCOPE_AGENT); }
__device__ __forceinline__ unsigned xb_add(unsigned* p, unsigned v) { return __hip_atomic_fetch_add(p, v, __ATOMIC_RELAXED, __HIP_MEMORY_SCOPE_AGENT); }
__device__ __forceinline__ unsigned xb_xcc_id() { return (unsigned)__builtin_amdgcn_s_getreg((3 << 11) | 20) & 0xFu; }
#define XB_SPIN(cond, bar) do { unsigned _sp = 0; while (cond) { __builtin_amdgcn_s_sleep(1); \
    if ((++_sp & 255u) == 0u) { if (xb_ld(&(bar)[XB_TMO])) break; if (_sp > XB_SPIN_CAP) { atomicAdd(&(bar)[XB_TMO], 1u); break; } } } } while (0)

struct XcdBarrier { unsigned* bar; unsigned x; volatile LAS unsigned* st; };

__device__ __forceinline__ XcdBarrier xcd_barrier_post(unsigned* bar, volatile LAS unsigned* st) {
    XcdBarrier b; b.bar = bar; b.x = xb_xcc_id(); b.st = st;
    if (threadIdx.x == 0) (void)xb_add(&bar[XB_XCNT(b.x)], 1u);
    return b;
}
__device__ __forceinline__ void xcd_barrier_complete(unsigned* bar, unsigned x, unsigned& nloc, unsigned& nx) {
    const unsigned G = gridDim.x * gridDim.y * gridDim.z;
    unsigned sum, cnt, mine, sp = 0u;
    for (;;) {
        sum = 0u; cnt = 0u; mine = 0u;
#pragma unroll
        for (unsigned j = 0; j < 16; ++j) { const unsigned c = xb_ld(&bar[XB_XCNT(j)]); sum += c; cnt += (c > 0u) ? 1u : 0u; mine = (j == x) ? c : mine; }
        if (sum == G) break;
        __builtin_amdgcn_s_sleep(1);
        if ((++sp & 255u) == 0u) { if (xb_ld(&bar[XB_TMO])) break; if (sp > XB_SPIN_CAP) { atomicAdd(&bar[XB_TMO], 1u); break; } }
    }
    nloc = mine > 0u ? mine : 1u; nx = cnt > 0u ? cnt : 1u;
}
__device__ __forceinline__ void xcd_barrier(const XcdBarrier& b) {
    asm volatile("s_waitcnt vmcnt(0)" ::: "memory");
    __syncthreads();
    if (threadIdx.x == 0) {
        unsigned* bar = b.bar;
        __builtin_amdgcn_s_waitcnt(0);
        unsigned nloc = b.st[0], nx = b.st[1];
        if (nloc == 0u) { xcd_barrier_complete(bar, b.x, nloc, nx); b.st[0] = nloc; b.st[1] = nx; }
        const unsigned old = xb_add(&bar[XB_XSUB(b.x)], 1u);
        const unsigned gen = old / nloc;
        if (old + 1u == (gen + 1u) * nloc) {
            __builtin_amdgcn_fence(__ATOMIC_RELEASE, "agent");
            asm volatile("s_waitcnt vmcnt(0)" ::: "memory");
            const unsigned og = xb_add(&bar[XB_TOP], 1u);
            const unsigned tg = og / nx;
            if (og + 1u == (tg + 1u) * nx) xb_add(&bar[XB_TOPGEN], 1u);
            else XB_SPIN(xb_ld(&bar[XB_TOPGEN]) == tg, bar);
            __builtin_amdgcn_fence(__ATOMIC_ACQUIRE, "agent");
            xb_add(&bar[XB_XGEN(b.x)], 1u);
            asm volatile("s_waitcnt vmcnt(0)" ::: "memory");
        } else {
            XB_SPIN(xb_ld(&bar[XB_XGEN(b.x)]) == gen, bar);
            __builtin_amdgcn_fence(__ATOMIC_ACQUIRE, "agent");
            asm volatile("s_waitcnt vmcnt(0)" ::: "memory");
        }
    }
    __syncthreads();
}

struct Args { const void* in[19]; float* out; unsigned char* ws; int ph_lo, ph_hi; };
enum { I_X = 0, I_POS, I_NORM_ATTN, I_W_IN, I_SINKS, I_CK_POS, I_CK_W1, I_CK_W2, I_CV_POS, I_CV_W1, I_CV_W2, I_W_OUT, I_NORM_FFN, I_W_QUERY, I_SK1, I_SK2, I_EDOWN, I_EUP, I_NORM_F };

constexpr int GT_LD = 72;
constexpr int GT_AS = 0, GT_BS = 128 * GT_LD * 2, GT_END = 2 * 128 * GT_LD * 2;
__device__ __forceinline__ void gemm_tile(const bf16* __restrict__ A, long lda, const bf16* __restrict__ Bt, long ldb, int K,
                                          LAS unsigned char* lds, f32x4 (&acc)[2][4], bool swap, int tid) {
    LAS bf16* As = (LAS bf16*)(lds + GT_AS);
    LAS bf16* Bs = (LAS bf16*)(lds + GT_BS);
    const int lane = tid & 63, w = tid >> 6, wr = w >> 1, wc = w & 1, fr = lane & 15, q = lane >> 4;
#pragma unroll
    for (int m = 0; m < 2; ++m)
#pragma unroll
        for (int n = 0; n < 4; ++n) acc[m][n] = (f32x4){0.f, 0.f, 0.f, 0.f};
    const int r0 = tid >> 3, kc = (tid & 7) * 8;
    for (int k0 = 0; k0 < K; k0 += 64) {
        u32x4 ra[2], rb[2];
#pragma unroll
        for (int i = 0; i < 2; ++i) {
            ra[i] = *(const u32x4*)(A + (long)(r0 + 64 * i) * lda + k0 + kc);
            rb[i] = *(const u32x4*)(Bt + (long)(r0 + 64 * i) * ldb + k0 + kc);
        }
        __syncthreads();
#pragma unroll
        for (int i = 0; i < 2; ++i) {
            *(LAS u32x4*)(As + (r0 + 64 * i) * GT_LD + kc) = ra[i];
            *(LAS u32x4*)(Bs + (r0 + 64 * i) * GT_LD + kc) = rb[i];
        }
        __syncthreads();
#pragma unroll
        for (int kk = 0; kk < 2; ++kk) {
            bf16x8 af[2], bfr[4];
#pragma unroll
            for (int m = 0; m < 2; ++m) af[m] = *(const LAS bf16x8*)(As + (32 * wr + 16 * m + fr) * GT_LD + 32 * kk + 8 * q);
#pragma unroll
            for (int n = 0; n < 4; ++n) bfr[n] = *(const LAS bf16x8*)(Bs + (64 * wc + 16 * n + fr) * GT_LD + 32 * kk + 8 * q);
            if (swap) {
#pragma unroll
                for (int m = 0; m < 2; ++m)
#pragma unroll
                    for (int n = 0; n < 4; ++n) acc[m][n] = __builtin_amdgcn_mfma_f32_16x16x32_bf16(bfr[n], af[m], acc[m][n], 0, 0, 0);
            } else {
#pragma unroll
                for (int m = 0; m < 2; ++m)
#pragma unroll
                    for (int n = 0; n < 4; ++n) acc[m][n] = __builtin_amdgcn_mfma_f32_16x16x32_bf16(af[m], bfr[n], acc[m][n], 0, 0, 0);
            }
        }
    }
    __syncthreads();
}

namespace pg8 {
#define PG8_LAS __attribute__((address_space(3)))
typedef unsigned short bf16_t;
typedef short bf16x8 __attribute__((ext_vector_type(8)));
typedef float f32x4 __attribute__((ext_vector_type(4)));
typedef unsigned u32x4 __attribute__((ext_vector_type(4)));
constexpr int BM = 256, BK = 64, HALF = 128, HTB = HALF * BK * 2  , STAGE_BYTES = 8 * HTB, NXCD = 8, WGM = 8;

__host__ __device__ __forceinline__ int lds_byte(int r, int c) { const int st = (r >> 4) * 2 + (c >> 5), rr = r & 15, cc = c & 31, ob = rr * 64 + cc * 2; return st * 1024 + (ob ^ (((ob >> 9) & 1) << 5)); }
__host__ __device__ __forceinline__ void stage_rc(int b, int& R, int& C) { const int st = b / 1024, sb = b % 1024, swz = sb ^ (((sb >> 9) & 1) << 5); R = (st >> 1) * 16 + swz / 64; C = (st & 1) * 32 + (swz % 64) / 2; }
__host__ __device__ __forceinline__ int perm32(int rho) { const int n = rho >> 4, i = rho & 15; return 8 * (i >> 2) + 4 * n + (i & 3); }

struct Unit { int pm, pn; };
struct Gemm { const bf16_t* A; const bf16_t* Bt; int M, N, K; };

struct StaticOrder {
    int nM, nN, nwg, G, c;
    __host__ __device__ void init(int M, int N, int G_, int c_) { nM = M / BM; nN = N / BM; nwg = nM * nN; G = G_; c = c_; }
    __host__ __device__ bool next(int i, Unit& u) const {
        const long L = (long)i * G + c; if (L >= nwg) return false;
        int wgid = (int)L; { const int q = nwg / NXCD, r = nwg % NXCD, xcd = wgid % NXCD, off = wgid / NXCD; wgid = (xcd < r ? xcd * (q + 1) : r * (q + 1) + (xcd - r) * q) + off; }
        const int nig = WGM * nN, gid = wgid / nig, fm = gid * WGM, gsz = (nM - fm) < WGM ? (nM - fm) : WGM;
        u.pm = fm + ((wgid % nig) % gsz); u.pn = (wgid % nig) / gsz; return true;
    }
    __device__ __forceinline__ void a_ready(const Unit&) const {}
    __device__ __forceinline__ void done(const Unit&) const {}
};

__device__ __forceinline__ unsigned cvt_pk_bf16(float lo, float hi) { unsigned r; asm volatile("v_cvt_pk_bf16_f32 %0, %1, %2" : "=v"(r) : "v"(lo), "v"(hi)); return r; }
typedef float f32x2 __attribute__((ext_vector_type(2)));
__device__ __forceinline__ f32x2 gelu_pk(f32x2 v) {
    const f32x2 av = __builtin_elementwise_abs(v), d = av * 0.2316418882f + 1.0f;
    f32x2 t; t.x = __builtin_amdgcn_rcpf(d.x); t.y = __builtin_amdgcn_rcpf(d.y);
    f32x2 q = t * 0.5307027145f + (-0.7265760135f); q = q * t + 0.7107068705f; q = q * t + (-0.142248368f); q = q * t + 0.127414796f; q = q * t;
    const f32x2 s = (v * v) * (-0.72134752044f);
    f32x2 e; e.x = __builtin_amdgcn_exp2f(s.x); e.y = __builtin_amdgcn_exp2f(s.y);
    const f32x2 m = v * (q * e), r = v - m;
    f32x2 o; o.x = v.x < 0.f ? m.x : r.x; o.y = v.y < 0.f ? m.y : r.y; return o;
}

template <int ACT  > struct EpiBf16 {
    static constexpr bool PERM = true, AFTER_DRAIN = false; static_assert(ACT == 0 || ACT == 1, "EpiBf16: ACT is 0 (none) or 1 (gelu_pk)");
    bf16_t* O; int ldc; const float* bias; int split_cols; size_t split_stride; float scale0;
    __device__ __forceinline__ void operator()(const f32x4 (&acc)[2][2][4][2], const Unit& u, int wr, int wc, int fr, int fq) const {
        const int row0 = u.pm * BM + wr * 64 + fr; int colt = u.pn * BM; bf16_t* base = O;
        float sc = 1.f; if (split_cols) { const int t = colt / split_cols; base += (size_t)t * split_stride; colt -= t * split_cols; if (t == 0) sc = scale0; }
        const int col0 = colt + wc * 32 + 8 * fq, bcol0 = u.pn * BM + wc * 32 + 8 * fq;
        f32x4 bv[2][2];
#pragma unroll
        for (int bj = 0; bj < 2; ++bj)
#pragma unroll
            for (int n = 0; n < 2; ++n) bv[bj][n] = bias ? *(const f32x4*)(bias + bcol0 + bj * HALF + 4 * n) : (f32x4){0.f, 0.f, 0.f, 0.f};
#pragma unroll
        for (int ai = 0; ai < 2; ++ai)
#pragma unroll
            for (int m = 0; m < 4; ++m) { bf16_t* rowp = base + (size_t)(row0 + ai * HALF + m * 16) * ldc + col0;
#pragma unroll
                for (int bj = 0; bj < 2; ++bj) { f32x4 v0 = acc[ai][bj][m][0] + bv[bj][0], v1 = acc[ai][bj][m][1] + bv[bj][1];
                    if (ACT == 1) { f32x2 a = gelu_pk((f32x2){v0[0], v0[1]}), b = gelu_pk((f32x2){v0[2], v0[3]}), c = gelu_pk((f32x2){v1[0], v1[1]}), d = gelu_pk((f32x2){v1[2], v1[3]});
                        v0 = (f32x4){a.x, a.y, b.x, b.y}; v1 = (f32x4){c.x, c.y, d.x, d.y}; }
                    v0 = v0 * sc; v1 = v1 * sc; u32x4 w; w.x = cvt_pk_bf16(v0[0], v0[1]); w.y = cvt_pk_bf16(v0[2], v0[3]); w.z = cvt_pk_bf16(v1[0], v1[1]); w.w = cvt_pk_bf16(v1[2], v1[3]);
                    *(u32x4*)(rowp + bj * HALF) = w; } }
    }
};
template <class Epi, class Sched, bool ALIGN_EPI = false, bool SP2 = false>
__device__ __forceinline__ void gemm_phase(PG8_LAS unsigned char* lds, const Gemm g, const Sched& S, const Epi& E) {
    int tid_ = threadIdx.x; asm volatile("" : "+v"(tid_));
    const int tid = tid_, wid = __builtin_amdgcn_readfirstlane(tid >> 6), lane = tid & 63, wr = wid >> 2, wc = wid & 3, fr = lane & 15, fq = lane >> 4;
    const int K = g.K, nt = K / BK;
    unsigned voffA[2], voffB[2];
#pragma unroll
    for (int i = 0; i < 2; ++i) { int R, C; stage_rc(tid * 16 + i * 8192, R, C); const int Rb = Epi::PERM ? ((R & ~31) + perm32(R & 31)) : R;
        voffA[i] = (unsigned)(R * K + C) * 2u; voffB[i] = (unsigned)(Rb * K + C) * 2u; }
    const size_t kstep = (size_t)(BK * 2);
    const size_t hstep = (size_t)HALF * K * 2;
    const size_t tstep = 2 * hstep;
    const unsigned ldsw = (unsigned)wid * 1024u;
    const int aoff = lds_byte(wr * 64 + fr, fq * 8), boff = lds_byte(wc * 32 + fr, fq * 8);
#define PG8_SA(b, h) (((b) * 2 + (h)) * HTB)
#define PG8_SB(b, h) ((4 + (b) * 2 + (h)) * HTB)
#define PG8_STAGE(bufoff, gbase, voff) do { _Pragma("unroll") for (int _i = 0; _i < 2; ++_i) \
        __builtin_amdgcn_global_load_lds((const unsigned*)((const char*)(gbase) + (voff)[_i]), (PG8_LAS unsigned*)(lds + (bufoff) + ldsw + _i * 8192), 16, 0, 0); } while (0)
#define PG8_LDA(dst, b, h) do { _Pragma("unroll") for (int m = 0; m < 4; ++m) _Pragma("unroll") for (int k = 0; k < 2; ++k) dst[m][k] = *(const PG8_LAS bf16x8*)(lds + PG8_SA(b, h) + aoff + m * 2048 + k * 1024); } while (0)
#define PG8_LDB(dst, b, h) do { _Pragma("unroll") for (int n = 0; n < 2; ++n) _Pragma("unroll") for (int k = 0; k < 2; ++k) dst[n][k] = *(const PG8_LAS bf16x8*)(lds + PG8_SB(b, h) + boff + n * 2048 + k * 1024); } while (0)
#define PG8_MMA(ai, bj, At, Bt) do { __builtin_amdgcn_s_setprio(1); _Pragma("unroll") for (int m = 0; m < 4; ++m) _Pragma("unroll") for (int n = 0; n < 2; ++n) _Pragma("unroll") for (int k = 0; k < 2; ++k) \
        acc[ai][bj][m][n] = __builtin_amdgcn_mfma_f32_16x16x32_bf16(Bt[n][k], At[m][k], acc[ai][bj][m][n], 0, 0, 0); __builtin_amdgcn_s_setprio(0); } while (0)
#define PG8_WAIT_V(n) asm volatile("s_waitcnt vmcnt(" #n ")" ::: "memory")
#define PG8_WAIT_L(n) asm volatile("s_waitcnt lgkmcnt(" #n ")" ::: "memory")
#define PG8_BAR __builtin_amdgcn_s_barrier()
#define PG8_SCHED __builtin_amdgcn_sched_barrier(0)
    Unit cur, nxt; int ui = 0;
    if (!S.next(0, cur)) return;
    f32x4 acc[2][2][4][2];
#pragma unroll
    for (int a = 0; a < 2; ++a)
#pragma unroll
        for (int b = 0; b < 2; ++b)
#pragma unroll
            for (int m = 0; m < 4; ++m)
#pragma unroll
                for (int n = 0; n < 2; ++n) acc[a][b][m][n] = (f32x4){0.f, 0.f, 0.f, 0.f};
    bf16x8 At[4][2], B0[2][2], B1[2][2];
    const char* cA = (const char*)g.A + (size_t)cur.pm * tstep; const char* cB = (const char*)g.Bt + (size_t)cur.pn * tstep;
    S.a_ready(cur);
    if constexpr (SP2) {
        PG8_STAGE(PG8_SB(0, 0), cB, voffB); PG8_STAGE(PG8_SB(0, 1), cB + hstep, voffB); PG8_STAGE(PG8_SA(0, 0), cA, voffA); PG8_STAGE(PG8_SA(0, 1), cA + hstep, voffA);
        if (wr == 1) PG8_BAR;
        PG8_WAIT_V(2); PG8_BAR;
        PG8_STAGE(PG8_SB(1, 0), cB + kstep, voffB); PG8_STAGE(PG8_SA(1, 0), cA + kstep, voffA); PG8_STAGE(PG8_SB(1, 1), cB + hstep + kstep, voffB);
        PG8_WAIT_V(6); PG8_BAR;
    } else {
        PG8_STAGE(PG8_SB(0, 0), cB, voffB); PG8_STAGE(PG8_SA(0, 0), cA, voffA); PG8_STAGE(PG8_SB(0, 1), cB + hstep, voffB); PG8_STAGE(PG8_SA(0, 1), cA + hstep, voffA);
        if (wr == 1) PG8_BAR;
        PG8_WAIT_V(4); PG8_BAR;
        PG8_STAGE(PG8_SB(1, 0), cB + kstep, voffB); PG8_STAGE(PG8_SA(1, 0), cA + kstep, voffA); PG8_STAGE(PG8_SB(1, 1), cB + hstep + kstep, voffB);
        PG8_WAIT_V(6); PG8_BAR;
    }
    for (;;) {
        const bool has_next = S.next(ui + 1, nxt);
        const char* nA = has_next ? (const char*)g.A + (size_t)nxt.pm * tstep : cA; const char* nB = has_next ? (const char*)g.Bt + (size_t)nxt.pn * tstep : cB;
        for (int t = 0; t < nt; t += 2) {
            const bool last = (t == nt - 2);
            const char* a1 = cA + (size_t)(t + 1) * kstep;
            const char* a2 = last ? nA : cA + (size_t)(t + 2) * kstep; const char* b2 = last ? nB : cB + (size_t)(t + 2) * kstep;
            const char* a3 = a2 + kstep; const char* b3 = b2 + kstep;
            if (last && has_next) S.a_ready(nxt);
            if constexpr (SP2) {
            PG8_LDB(B0, 0, 0); PG8_LDB(B1, 0, 1); PG8_SCHED; PG8_LDA(At, 0, 0); PG8_STAGE(PG8_SA(1, 1), a1 + hstep, voffA);
            PG8_WAIT_V(8); PG8_WAIT_L(0); PG8_BAR; PG8_MMA(0, 0, At, B0); PG8_MMA(0, 1, At, B1); PG8_BAR; PG8_SCHED;
            PG8_LDA(At, 0, 1); PG8_STAGE(PG8_SB(0, 0), b2, voffB); PG8_STAGE(PG8_SB(0, 1), b2 + hstep, voffB); PG8_STAGE(PG8_SA(0, 0), a2, voffA);
            PG8_WAIT_V(8); PG8_WAIT_L(0); PG8_BAR; PG8_MMA(1, 0, At, B0); PG8_MMA(1, 1, At, B1); PG8_BAR; PG8_SCHED;
            PG8_LDB(B0, 1, 0); PG8_LDB(B1, 1, 1); PG8_SCHED; PG8_LDA(At, 1, 0); PG8_STAGE(PG8_SA(0, 1), a2 + hstep, voffA);
            PG8_WAIT_V(8); PG8_WAIT_L(0); PG8_BAR; PG8_MMA(0, 0, At, B0); PG8_MMA(0, 1, At, B1); PG8_BAR; PG8_SCHED;
            PG8_LDA(At, 1, 1); PG8_STAGE(PG8_SB(1, 0), b3, voffB); PG8_STAGE(PG8_SB(1, 1), b3 + hstep, voffB); PG8_STAGE(PG8_SA(1, 0), a3, voffA);
            PG8_WAIT_V(8); PG8_WAIT_L(0); PG8_BAR; PG8_MMA(1, 0, At, B0); PG8_MMA(1, 1, At, B1); PG8_BAR; PG8_SCHED;
            } else {
            PG8_LDB(B0, 0, 0); PG8_SCHED; PG8_LDA(At, 0, 0); PG8_STAGE(PG8_SA(1, 1), a1 + hstep, voffA);
            PG8_WAIT_L(8); PG8_BAR; PG8_WAIT_L(0); PG8_MMA(0, 0, At, B0); PG8_BAR; PG8_SCHED;
            PG8_LDB(B1, 0, 1); PG8_STAGE(PG8_SB(0, 0), b2, voffB);
            PG8_BAR; PG8_WAIT_L(0); PG8_MMA(0, 1, At, B1); PG8_BAR;
            PG8_LDA(At, 0, 1); PG8_STAGE(PG8_SA(0, 0), a2, voffA);
            PG8_BAR; PG8_WAIT_L(0); PG8_MMA(1, 0, At, B0); PG8_BAR; PG8_SCHED;
            PG8_STAGE(PG8_SB(0, 1), b2 + hstep, voffB);
            PG8_WAIT_V(6); PG8_BAR; PG8_MMA(1, 1, At, B1); PG8_BAR;
            PG8_LDB(B0, 1, 0); PG8_SCHED; PG8_LDA(At, 1, 0); PG8_STAGE(PG8_SA(0, 1), a2 + hstep, voffA);
            PG8_WAIT_L(8); PG8_BAR; PG8_WAIT_L(0); PG8_MMA(0, 0, At, B0); PG8_BAR; PG8_SCHED;
            PG8_LDB(B1, 1, 1); PG8_STAGE(PG8_SB(1, 0), b3, voffB);
            PG8_BAR; PG8_WAIT_L(0); PG8_MMA(0, 1, At, B1); PG8_BAR;
            PG8_LDA(At, 1, 1); PG8_STAGE(PG8_SA(1, 0), a3, voffA);
            PG8_BAR; PG8_WAIT_L(0); PG8_MMA(1, 0, At, B0); PG8_BAR; PG8_SCHED;
            PG8_STAGE(PG8_SB(1, 1), b3 + hstep, voffB);
            PG8_WAIT_V(6); PG8_BAR; PG8_MMA(1, 1, At, B1); PG8_BAR;
            }
        }
        if constexpr (ALIGN_EPI) { if (wr == 0) PG8_BAR; }
        if constexpr (!Epi::AFTER_DRAIN) { E(acc, cur, wr, wc, fr, fq); S.done(cur); }
        if (!has_next) break;
#pragma unroll
        for (int a = 0; a < 2; ++a)
#pragma unroll
            for (int b = 0; b < 2; ++b)
#pragma unroll
                for (int m = 0; m < 4; ++m)
#pragma unroll
                    for (int n = 0; n < 2; ++n) acc[a][b][m][n] = (f32x4){0.f, 0.f, 0.f, 0.f};
        cur = nxt; cA = nA; cB = nB; ++ui;
        if constexpr (ALIGN_EPI) { if (wr == 1) PG8_BAR; }
    }
    PG8_WAIT_V(0);
    if constexpr (!ALIGN_EPI) { if (wr == 0) PG8_BAR; }
    PG8_BAR;
    if constexpr (Epi::AFTER_DRAIN) { E.fused(acc, cur, wr, wc, fr, fq, lds, wid, lane); S.done(cur); }
#undef PG8_SA
#undef PG8_SB
#undef PG8_STAGE
#undef PG8_LDA
#undef PG8_LDB
#undef PG8_MMA
#undef PG8_WAIT_V
#undef PG8_WAIT_L
#undef PG8_BAR
#undef PG8_SCHED
}
}

__host__ __device__ __forceinline__ int inproj_col(int n) { const int p = n & 63, g = p >> 3, j = p & 7; return (n & ~63) + ((j < 4) ? 4 * g + j : 32 + 4 * g + (j - 4)); }
__device__ __forceinline__ void transpose_w(const float* __restrict__ W, int K, int Nsrc, int col_off, int nvalid, int Npad, bool perm, bf16* __restrict__ WT, long gtid, long ngt, const float* __restrict__ kgain = nullptr) {
    const long items = (long)Npad * (K / 8);
    for (long it = gtid; it < items; it += ngt) {
        const int n = (int)(it % Npad), kc = (int)(it / Npad) * 8;
        const int sc = col_off + (perm ? inproj_col(n) : n);
        float v[8];
#pragma unroll
        for (int j = 0; j < 8; ++j) v[j] = (n < nvalid) ? W[(long)(kc + j) * Nsrc + sc] * (kgain ? kgain[kc + j] : 1.0f) : 0.f;
        u32x4 o; o.x = pk2(v[0], v[1]); o.y = pk2(v[2], v[3]); o.z = pk2(v[4], v[5]); o.w = pk2(v[6], v[7]);
        *(u32x4*)(WT + (long)n * K + kc) = o;
    }
}
__device__ __forceinline__ void convert_bf16(const float* __restrict__ src, bf16* __restrict__ dst, long n, long gtid, long ngt) {
    for (long i = gtid * 8; i < n; i += ngt * 8) {
        const f32x4 a = *(const f32x4*)(src + i), b = *(const f32x4*)(src + i + 4);
        u32x4 o; o.x = pk2(a[0], a[1]); o.y = pk2(a[2], a[3]); o.z = pk2(b[0], b[1]); o.w = pk2(b[2], b[3]);
        *(u32x4*)(dst + i) = o;
    }
}
__device__ __forceinline__ void rms_row_bf16(const float* __restrict__ xrow, const float* __restrict__ g, bf16* __restrict__ orow, int lane) {
    f32x4 v[4]; float ss = 0.f;
#pragma unroll
    for (int j = 0; j < 4; ++j) { v[j] = *(const f32x4*)(xrow + (lane + 64 * j) * 4); ss += (v[j][0] * v[j][0] + v[j][1] * v[j][1]) + (v[j][2] * v[j][2] + v[j][3] * v[j][3]); }
    const float r = rsqrtf(wave_sum(ss) * (1.0f / D) + RMS_EPS);
#pragma unroll
    for (int j = 0; j < 4; ++j) {
        const f32x4 gg = *(const f32x4*)(g + (lane + 64 * j) * 4);
        u32x2 o; o.x = pk2(v[j][0] * r * gg[0], v[j][1] * r * gg[1]); o.y = pk2(v[j][2] * r * gg[2], v[j][3] * r * gg[3]);
        *(u32x2*)(orow + (lane + 64 * j) * 4) = o;
    }
}

__device__ __forceinline__ void quant_experts(const Args& a, int lane, int gw, int ngw, int r_lo, int r_hi) {
    unsigned char* ws = a.ws;
    for (int r = r_lo + gw; r < r_hi; r += ngw) {
        const int up = r >= 16384, e = r & 16383;
        const float* src = (const float*)a.in[up ? I_EUP : I_EDOWN] + (size_t)e * D;
        f32x4 v[4]; float am = 0.f, ssq = 0.f;
#pragma unroll
        for (int j = 0; j < 4; ++j) { v[j] = *(const f32x4*)(src + (lane + 64 * j) * 4); am = fmaxf(am, fmaxf(fmaxf(fabsf(v[j][0]), fabsf(v[j][1])), fmaxf(fabsf(v[j][2]), fabsf(v[j][3]))));
            ssq += (v[j][0] * v[j][0] + v[j][1] * v[j][1]) + (v[j][2] * v[j][2] + v[j][3] * v[j][3]); }
#pragma unroll
        for (int o = 1; o < 64; o <<= 1) { am = fmaxf(am, __shfl_xor(am, o)); ssq += __shfl_xor(ssq, o); }
        am = fmaxf(am, 1e-30f);
        {
            const float cl = fmaxf(fminf(am, 2.6f * sqrtf(ssq * (1.0f / D))), 1e-30f), inv = 7.0f / cl;
            unsigned char* dst = ws + (up ? WS_EUP : WS_EDOWN) + (size_t)e * 128;
#pragma unroll
            for (int j = 0; j < 4; ++j) {
                unsigned w = 0;
#pragma unroll
                for (int c = 0; c < 4; ++c) w |= ((unsigned)((int)fminf(fmaxf(rintf(v[j][c] * inv), -7.f), 7.f) + ((up && !(c & 1)) ? 8 : 0)) & 0xfu) << (4 * c);
                const int d = (lane + 64 * j) * 4;
                *(unsigned short*)(dst + (size_t)(d >> 8) * 16384 * 128 + ((d & 255) >> 1)) = (unsigned short)w;
            }
            if (lane == 0) ((float*)(ws + (up ? WS_ESU : WS_ESD)))[e] = cl * (1.0f / 7.0f);
        }
    }
}

__device__ __forceinline__ void phase0(const Args& a, int tid) {
    unsigned char* ws = a.ws;
    const long gtid = (long)blockIdx.x * 512 + tid, ngt = (long)gridDim.x * 512;
    const int lane = tid & 63, gw = blockIdx.x * 8 + (tid >> 6), ngw = gridDim.x * 8;
    transpose_w((const float*)a.in[I_W_IN], D, INW, 0, 2048, 2048, true, (bf16*)(ws + WS_WIN_T), gtid, ngt);
    transpose_w((const float*)a.in[I_W_IN], D, INW, 2048, 24, 128, false, (bf16*)(ws + WS_WG_T), gtid, ngt);
    transpose_w((const float*)a.in[I_W_OUT], D, D, 0, D, D, false, (bf16*)(ws + WS_WOUT_T), gtid, ngt);
    transpose_w((const float*)a.in[I_W_QUERY], D, 2048, 0, 2048, 2048, false, (bf16*)(ws + WS_WQ_T), gtid, ngt, (const float*)a.in[I_NORM_FFN]);
    transpose_w((const float*)a.in[I_CK_W1], 2048, 256, 0, 256, 256, false, (bf16*)(ws + WS_CW1_T), gtid, ngt);
    transpose_w((const float*)a.in[I_CV_W1], 2048, 256, 0, 256, 256, false, (bf16*)(ws + WS_CW1_T) + 256 * 2048, gtid, ngt);
    transpose_w((const float*)a.in[I_CK_W2], 256, 64, 0, 64, 128, false, (bf16*)(ws + WS_CW2_T), gtid, ngt);
    transpose_w((const float*)a.in[I_CV_W2], 256, 64, 0, 64, 128, false, (bf16*)(ws + WS_CW2_T) + 128 * 256, gtid, ngt);
    convert_bf16((const float*)a.in[I_SK1], (bf16*)(ws + WS_SUBK), 128 * 128, gtid, ngt);
    convert_bf16((const float*)a.in[I_SK2], (bf16*)(ws + WS_SUBK) + 128 * 128, 128 * 128, gtid, ngt);
    if (gw == 0) {
        const float* nf = (const float*)a.in[I_NORM_FFN]; float m = 0.f;
        for (int k = lane; k < D; k += 64) m = fmaxf(m, fabsf(nf[k]));
#pragma unroll
        for (int o = 1; o < 64; o <<= 1) m = fmaxf(m, __shfl_xor(m, o));
        if (lane == 0) *(float*)(ws + WS_GMAX) = fmaxf(m, 1e-30f);
    }
    for (int o = gw; o < 512; o += ngw) {
        const int ten = o >> 8, n = o & 255;
        const float* pos = (const float*)a.in[ten ? I_CV_POS : I_CK_POS];
        const float* w1 = (const float*)a.in[ten ? I_CV_W1 : I_CK_W1];
        float s = 0.f;
        for (int k = lane; k < 2048; k += 64) s += pos[k] * w1[(long)k * 256 + n];
        s = wave_sum(s);
        if (lane == 0) ((float*)(ws + WS_CB1))[o] = s;
    }
    {
        const int* pos = (const int*)a.in[I_POS];
        float* rc = (float*)(ws + WS_ROPE_C); float* rs = (float*)(ws + WS_ROPE_S);
        for (long it = gtid; it < (long)NTOK * 32; it += ngt) {
            const int tok = (int)(it >> 5), f = (int)(it & 31);
            const float inv = powf(10000.0f, -(float)f / 32.0f);
            const float ang = (float)pos[tok] * inv;
            float sv, cv; sincosf(ang, &sv, &cv);
            rc[it] = cv; rs[it] = sv;
        }
    }
    if (gw < NTOK) {
        const float* X = (const float*)a.in[I_X]; const float* gn = (const float*)a.in[I_NORM_ATTN];
        f32x4 v[4], nx[4], gg4[4];
#pragma unroll
        for (int j = 0; j < 4; ++j) { v[j] = *(const f32x4*)(X + (long)gw * D + (lane + 64 * j) * 4); gg4[j] = *(const f32x4*)(gn + (lane + 64 * j) * 4); }
        for (int r = gw; r < NTOK; r += ngw) {
            const float* nrow = X + (long)min(r + ngw, NTOK - 1) * D;
#pragma unroll
            for (int j = 0; j < 4; ++j) nx[j] = *(const f32x4*)(nrow + (lane + 64 * j) * 4);
            float ss = 0.f;
#pragma unroll
            for (int j = 0; j < 4; ++j) ss += (v[j][0] * v[j][0] + v[j][1] * v[j][1]) + (v[j][2] * v[j][2] + v[j][3] * v[j][3]);
            const float rr = rsqrtf(wave_sum(ss) * (1.0f / D) + RMS_EPS);
            bf16* orow = (bf16*)(ws + WS_H) + (long)r * D;
#pragma unroll
            for (int j = 0; j < 4; ++j) {
                const f32x4 gg = gg4[j];
                u32x2 o; o.x = pk2(v[j][0] * rr * gg[0], v[j][1] * rr * gg[1]); o.y = pk2(v[j][2] * rr * gg[2], v[j][3] * rr * gg[3]);
                *(u32x2*)(orow + (lane + 64 * j) * 4) = o;
            }
#pragma unroll
            for (int j = 0; j < 4; ++j) v[j] = nx[j];
        }
    }
}

constexpr float QSCALE = 0.125f * 1.4426950408889634f;
struct EpiInProj {
    static constexpr bool PERM = true, AFTER_DRAIN = false;
    bf16* QKV;
    const float* RC;
    __device__ __forceinline__ void operator()(const f32x4 (&acc)[2][2][4][2], const pg8::Unit& u, int wr, int wc, int fr, int fq) const {
        const int b = (u.pm * 256) / T, tb = (u.pm * 256) % T, d0 = 16 * (wc & 1) + 4 * fq;
#pragma unroll
        for (int bj = 0; bj < 2; ++bj) {
            const int cb = 4 * u.pn + 2 * bj + (wc >> 1);
            const bool isq = (cb < 8) || (cb >= 12 && cb < 20);
            const int hq = cb < 8 ? cb : cb - 4, ti = cb < 12 ? ((cb - 8) >> 1) : 2 + ((cb - 20) >> 1);
            const bool rope = isq || ((ti & 1) == 0);
            const float sc = isq ? QSCALE : 1.0f;
            const unsigned eoff = isq ? (unsigned)((b * 16 + hq) * T) * 64u : (unsigned)(NB * 16 * T * 64) + (unsigned)ti * (unsigned)KV_TENSOR + (unsigned)((b * 2 + (cb & 1)) * T) * 64u;
            bf16* base = QKV + eoff;
#pragma unroll
            for (int ai = 0; ai < 2; ++ai)
#pragma unroll
                for (int m = 0; m < 4; ++m) {
                    const int t = tb + 128 * ai + 64 * wr + 16 * m + fr;
                    f32x4 o1 = acc[ai][bj][m][0], o2 = acc[ai][bj][m][1];
                    if (rope) {
                        const float* rp = RC + ((size_t)b * T + t) * 32 + d0;
                        const f32x4 c4 = *(const f32x4*)rp, s4 = *(const f32x4*)(rp + (size_t)NTOK * 32);
                        const f32x4 x1 = o1, x2 = o2;
                        o1 = (x1 * c4 - x2 * s4) * sc; o2 = (x2 * c4 + x1 * s4) * sc;
                    }
                    u32x2 w1; w1.x = pk2(o1[0], o1[1]); w1.y = pk2(o1[2], o1[3]);
                    u32x2 w2; w2.x = pk2(o2[0], o2[1]); w2.y = pk2(o2[2], o2[3]);
                    *(u32x2*)(base + (size_t)t * 64 + d0) = w1;
                    *(u32x2*)(base + (size_t)t * 64 + 32 + d0) = w2;
                }
        }
    }
};
__device__ __forceinline__ void phase1(const Args& a, LAS unsigned char* lds, int tid) {
    unsigned char* ws = a.ws;
    {
        pg8::Gemm g{(const bf16*)(ws + WS_H), (const bf16*)(ws + WS_WIN_T), NTOK, 2048, D};
        pg8::StaticOrder S; S.init(NTOK, 2048, (int)gridDim.x, (int)blockIdx.x);
        EpiInProj E{(bf16*)(ws + WS_Q), (const float*)(ws + WS_ROPE_C)};
        static_assert(WS_KV == WS_Q + (size_t)NB * 16 * T * 64 * 2 && WS_ROPE_S == WS_ROPE_C + (size_t)NTOK * 32 * 4, "EpiInProj layout assumptions");
        pg8::gemm_phase<EpiInProj, pg8::StaticOrder, true, true>(lds, g, S, E);
    }
}

__device__ __forceinline__ void gates_gemm(const Args& a, LAS unsigned char* lds, int tid, int first, int step) {
    unsigned char* ws = a.ws;
    const bf16* H = (const bf16*)(ws + WS_H); const bf16* WG = (const bf16*)(ws + WS_WG_T); float* G = (float*)(ws + WS_GATES);
    const int lane = tid & 63, w = tid >> 6, wr = w >> 1, wc = w & 1, fr = lane & 15, q = lane >> 4;
    for (int pm = first; pm < NTOK / 128; pm += step) {
        f32x4 acc[2][4];
        gemm_tile(H + (long)pm * 128 * D, D, WG, D, D, lds, acc, true, tid);
        if (wc == 0) {
#pragma unroll
            for (int m = 0; m < 2; ++m) {
                const long tok = (long)pm * 128 + 32 * wr + 16 * m + fr;
#pragma unroll
                for (int n = 0; n < 2; ++n)
#pragma unroll
                    for (int r = 0; r < 4; ++r) { const int col = 16 * n + 4 * q + r; if (col < 24) G[tok * 24 + col] = 1.0f / (1.0f + __expf(-acc[m][n][r])); }
            }
        }
    }
}

constexpr int P2_EXPERT_ROWS = 4096;
__device__ __forceinline__ void phase2(const Args& a, LAS unsigned char* lds, int tid) {
    unsigned char* ws = a.ws;
    const bf16* KR = (const bf16*)(ws + WS_KV); const bf16* W1 = (const bf16*)(ws + WS_CW1_T); const float* B1 = (const float*)(ws + WS_CB1);
    bf16* HID = (bf16*)(ws + WS_CHID);
    const int lane = tid & 63, w = tid >> 6, wr = w >> 1, wc = w & 1, fr = lane & 15, q = lane >> 4;
    const bool split = gridDim.x >= 256;
    const int nmain = split ? 128 : (int)gridDim.x, nside = split ? (int)gridDim.x - 128 : (int)gridDim.x, si = split ? (int)blockIdx.x - 128 : (int)blockIdx.x;
    if (!split || blockIdx.x >= 128) {
        gates_gemm(a, lds, tid, si, nside);
        quant_experts(a, lane, si * 8 + w, nside * 8, 0, P2_EXPERT_ROWS);
    }
    if (split && blockIdx.x >= 128) return;
    for (int u = blockIdx.x; u < 32 * 4; u += nmain) {
        const int z = u >> 2, pm = (u >> 1) & 1, pn = u & 1, ten = z >> 4, bh = z & 15;
        const bf16* A = KR + (size_t)(ten ? 3 : 2) * KV_TENSOR + (size_t)bh * T * 64 + (size_t)pm * 128 * 1024;
        f32x4 acc[2][4];
        gemm_tile(A, 1024, W1 + (size_t)ten * 256 * 2048 + (size_t)pn * 128 * 2048, 2048, 2048, lds, acc, true, tid);
#pragma unroll
        for (int m = 0; m < 2; ++m) {
            const int row = pm * 128 + 32 * wr + 16 * m + fr;
#pragma unroll
            for (int n = 0; n < 4; ++n) {
                const int col = pn * 128 + 64 * wc + 16 * n + 4 * q;
                const f32x4 bb = *(const f32x4*)(B1 + ten * 256 + col);
                f32x4 v = acc[m][n] + bb;
                u32x2 o; o.x = pk2(gelu_erf(v[0]), gelu_erf(v[1])); o.y = pk2(gelu_erf(v[2]), gelu_erf(v[3]));
                *(u32x2*)(HID + ((size_t)z * 256 + row) * 256 + col) = o;
            }
        }
    }
}
__device__ __forceinline__ void phase3(const Args& a, LAS unsigned char* lds, int tid) {
    unsigned char* ws = a.ws;
    const bf16* HID = (const bf16*)(ws + WS_CHID); const bf16* W2 = (const bf16*)(ws + WS_CW2_T);
    bf16* KC = (bf16*)(ws + WS_KCMP); bf16* VC = (bf16*)(ws + WS_VCMP);
    const int lane = tid & 63, w = tid >> 6, wr = w >> 1, wc = w & 1, fr = lane & 15, q = lane >> 4;
    const bool split = gridDim.x >= 128;
    const int nmain = split ? 64 : (int)gridDim.x, nside = split ? (int)gridDim.x - 64 : (int)gridDim.x, si = split ? (int)blockIdx.x - 64 : (int)blockIdx.x;
    if (!split || blockIdx.x >= 64) quant_experts(a, lane, si * 8 + w, nside * 8, P2_EXPERT_ROWS, 2 * 16384);
    if (split && blockIdx.x >= 64) return;
    for (int u = blockIdx.x; u < 32 * 2; u += nmain) {
        const int z = u >> 1, pm = u & 1, ten = z >> 4, bh = z & 15;
        f32x4 acc[2][4];
        gemm_tile(HID + ((size_t)z * 256 + pm * 128) * 256, 256, W2 + (size_t)ten * 128 * 256, 256, 256, lds, acc, true, tid);
        if (wc == 0) {
            bf16* dst = ten ? VC : KC;
#pragma unroll
            for (int m = 0; m < 2; ++m) {
                const int c = pm * 128 + 32 * wr + 16 * m + fr;
#pragma unroll
                for (int n = 0; n < 4; ++n) {
                    u32x2 o; o.x = pk2(acc[m][n][0], acc[m][n][1]); o.y = pk2(acc[m][n][2], acc[m][n][3]);
                    if (c == 255) { o.x = 0u; o.y = 0u; }
                    *(u32x2*)(dst + ((size_t)bh * 256 + c) * 64 + 16 * n + 4 * q) = o;
                }
            }
        }
    }
}

constexpr int AT_LD = 72;
constexpr int AT_TILE = 64 * AT_LD * 2;
constexpr int AT_IMP = 8 * AT_TILE, AT_SELM = AT_IMP + 4 * 64 * 64 * 4, AT_END = AT_SELM + 512;
#define AT_KBUF(lds, slot) ((LAS bf16*)((lds) + (slot) * 2 * AT_TILE))
#define AT_VBUF(lds, slot) ((LAS bf16*)((lds) + (slot) * 2 * AT_TILE + AT_TILE))
static_assert(AT_END <= LDS_JOB, "attention LDS map");
struct AttnAcc { f32x4 o[4][2]; f32x4 ls[2]; float m[2], l[2]; };
__device__ __forceinline__ float attn_rowsum(const AttnAcc& st, int qs);

__device__ __forceinline__ u32x4 tile_fetch(const bf16* __restrict__ src  , int tid) { return *(const u32x4*)(src + (size_t)tid * 8); }
__device__ __forceinline__ void tile_commit(LAS bf16* dst, const u32x4 v, int tid) { *(LAS u32x4*)(dst + (tid >> 3) * AT_LD + (tid & 7) * 8) = v; }
__device__ __forceinline__ void load_qfrag(bf16x8 (&qf)[2][2], const bf16* __restrict__ qbase  , int lane) {
    const int fr = lane & 15, q = lane >> 4;
#pragma unroll
    for (int qs = 0; qs < 2; ++qs)
#pragma unroll
        for (int kk = 0; kk < 2; ++kk) qf[qs][kk] = *(const bf16x8*)(qbase + (size_t)(16 * qs + fr) * 64 + 32 * kk + 8 * q);
}
__device__ __forceinline__ void qk_tile(const LAS bf16* Ks, const bf16x8 (&qf)[2][2], f32x4 (&s)[4][2], int lane) {
    const int fr = lane & 15, q = lane >> 4;
#pragma unroll
    for (int ks = 0; ks < 4; ++ks) {
        s[ks][0] = (f32x4){0.f, 0.f, 0.f, 0.f}; s[ks][1] = (f32x4){0.f, 0.f, 0.f, 0.f};
#pragma unroll
        for (int kk = 0; kk < 2; ++kk) {
            const bf16x8 kf = *(const LAS bf16x8*)(Ks + (16 * ks + fr) * AT_LD + 32 * kk + 8 * q);
            s[ks][0] = __builtin_amdgcn_mfma_f32_16x16x32_bf16(kf, qf[0][kk], s[ks][0], 0, 0, 0);
            s[ks][1] = __builtin_amdgcn_mfma_f32_16x16x32_bf16(kf, qf[1][kk], s[ks][1], 0, 0, 0);
        }
    }
}
typedef short v4i16_t __attribute__((ext_vector_type(4)));
__device__ __forceinline__ void pv_tile(LAS bf16* Vs, const f32x4 (&p)[4][2], f32x4 (&o)[4][2], int lane) {
    const int fr = lane & 15, q = lane >> 4;
    bf16x8 pf[2][2];
#pragma unroll
    for (int qs = 0; qs < 2; ++qs)
#pragma unroll
        for (int kp = 0; kp < 2; ++kp) {
            u32x4 t; t.x = pk2(p[2 * kp][qs][0], p[2 * kp][qs][1]); t.y = pk2(p[2 * kp][qs][2], p[2 * kp][qs][3]);
            t.z = pk2(p[2 * kp + 1][qs][0], p[2 * kp + 1][qs][1]); t.w = pk2(p[2 * kp + 1][qs][2], p[2 * kp + 1][qs][3]);
            pf[qs][kp] = __builtin_bit_cast(bf16x8, t);
        }
    __builtin_amdgcn_sched_barrier(0);
#pragma unroll
    for (int ds = 0; ds < 4; ++ds)
#pragma unroll
        for (int kp = 0; kp < 2; ++kp) {
            const v4i16_t lo = __builtin_amdgcn_ds_read_tr16_b64_v4i16((LAS v4i16_t*)(Vs + (32 * kp + 4 * q + (fr >> 2)) * AT_LD + 16 * ds + 4 * (fr & 3)));
            const v4i16_t hi = __builtin_amdgcn_ds_read_tr16_b64_v4i16((LAS v4i16_t*)(Vs + (32 * kp + 16 + 4 * q + (fr >> 2)) * AT_LD + 16 * ds + 4 * (fr & 3)));
            const bf16x8 vf = __builtin_shufflevector(lo, hi, 0, 1, 2, 3, 4, 5, 6, 7);
            o[ds][0] = __builtin_amdgcn_mfma_f32_16x16x32_bf16(vf, pf[0][kp], o[ds][0], 0, 0, 0);
            o[ds][1] = __builtin_amdgcn_mfma_f32_16x16x32_bf16(vf, pf[1][kp], o[ds][1], 0, 0, 0);
        }
    __builtin_amdgcn_sched_barrier(0);
}
__device__ __forceinline__ float max2f(float a, float b) { float r; asm("v_max_f32_e32 %0, %1, %2" : "=v"(r) : "v"(a), "v"(b)); return r; }
__device__ __forceinline__ float max3f(float a, float b, float c) { float r; asm("v_max3_f32 %0, %1, %2, %3" : "=v"(r) : "v"(a), "v"(b), "v"(c)); return r; }
__device__ __forceinline__ float quad_max(float x) {
    const unsigned u = __float_as_uint(x);
    const auto r = __builtin_amdgcn_permlane16_swap(u, u, false, false);
    const unsigned v = __float_as_uint(max2f(__uint_as_float(r[0]), __uint_as_float(r[1])));
    const auto r2 = __builtin_amdgcn_permlane32_swap(v, v, false, false);
    return max2f(__uint_as_float(r2[0]), __uint_as_float(r2[1]));
}
template <class MaskF>
__device__ __forceinline__ void softmax_tile(f32x4 (&s)[4][2], AttnAcc& st, int lane, int key0, int qtok0, MaskF mask, bool rescale_o) {
    const int fr = lane & 15, q = lane >> 4;
#pragma unroll
    for (int qs = 0; qs < 2; ++qs) {
        const int qtok = qtok0 + 16 * qs + fr;
        float mx = -1e30f;
#pragma unroll
        for (int ks = 0; ks < 4; ++ks)
#pragma unroll
            for (int r = 0; r < 4; ++r) {
                const int key = key0 + 16 * ks + 4 * q + r;
                const float v = mask(qtok, key) ? s[ks][qs][r] : -1e30f;
                s[ks][qs][r] = v; mx = fmaxf(mx, v);
            }
        mx = quad_max(mx);
        const float mnew = fmaxf(st.m[qs], mx);
        const float alpha = __builtin_amdgcn_exp2f(st.m[qs] - mnew);
        float sum = 0.f;
#pragma unroll
        for (int ks = 0; ks < 4; ++ks)
#pragma unroll
            for (int r = 0; r < 4; ++r) {
                const float v = s[ks][qs][r];
                const float p = (v > -1e29f) ? __builtin_amdgcn_exp2f(v - mnew) : 0.f;
                s[ks][qs][r] = p; sum += p;
            }
        st.l[qs] = st.l[qs] * alpha + sum; st.m[qs] = mnew;
        if (rescale_o) {
            st.ls[qs] = st.ls[qs] * alpha;
#pragma unroll
            for (int ds = 0; ds < 4; ++ds) st.o[ds][qs] = st.o[ds][qs] * alpha;
        }
    }
}
__device__ __forceinline__ void attn_tile_fast(AttnAcc& st, const bf16x8 (&qf)[2][2], const LAS bf16* Ks, LAS bf16* Vs, bool ok0, bool ok1, int lane) {
    const int fr = lane & 15, q = lane >> 4;
    float mu[2]; bool un[2]; f32x4 c4[2];
#pragma unroll
    for (int qs = 0; qs < 2; ++qs) {
        const bool ok = qs ? ok1 : ok0;
        un[qs] = st.m[qs] < -1e29f; mu[qs] = un[qs] ? 0.f : st.m[qs];
        const float c = ok ? -mu[qs] : -1e30f;
        c4[qs] = (f32x4){c, c, c, c};
    }
    f32x4 s[4][2];
#pragma unroll
    for (int ks = 0; ks < 4; ++ks) {
        const bf16x8 kf0 = *(const LAS bf16x8*)(Ks + (16 * ks + fr) * AT_LD + 8 * q), kf1 = *(const LAS bf16x8*)(Ks + (16 * ks + fr) * AT_LD + 32 + 8 * q);
        s[ks][0] = __builtin_amdgcn_mfma_f32_16x16x32_bf16(kf0, qf[0][0], c4[0], 0, 0, 0);
        s[ks][1] = __builtin_amdgcn_mfma_f32_16x16x32_bf16(kf0, qf[1][0], c4[1], 0, 0, 0);
        s[ks][0] = __builtin_amdgcn_mfma_f32_16x16x32_bf16(kf1, qf[0][1], s[ks][0], 0, 0, 0);
        s[ks][1] = __builtin_amdgcn_mfma_f32_16x16x32_bf16(kf1, qf[1][1], s[ks][1], 0, 0, 0);
    }
    float mx[2]; bool rec[2];
#pragma unroll
    for (int qs = 0; qs < 2; ++qs) {
        float m = max3f(s[0][qs][0], s[0][qs][1], s[0][qs][2]);
        m = max3f(m, s[0][qs][3], s[1][qs][0]); m = max3f(m, s[1][qs][1], s[1][qs][2]); m = max3f(m, s[1][qs][3], s[2][qs][0]);
        m = max3f(m, s[2][qs][1], s[2][qs][2]); m = max3f(m, s[2][qs][3], s[3][qs][0]); m = max3f(m, s[3][qs][1], s[3][qs][2]);
        m = max2f(m, s[3][qs][3]);
        mx[qs] = quad_max(m);
        const bool ok = qs ? ok1 : ok0;
        rec[qs] = ok & ((mx[qs] > 8.0f) | (un[qs] & (mx[qs] < -8.0f)));
    }
    if (__any(rec[0] || rec[1])) {
        asm volatile("" ::: "memory");
#pragma unroll
        for (int qs = 0; qs < 2; ++qs) {
            const float d = rec[qs] ? mx[qs] : 0.f, alpha = un[qs] ? 1.0f : __builtin_amdgcn_exp2f(-d);
#pragma unroll
            for (int ks = 0; ks < 4; ++ks) s[ks][qs] = s[ks][qs] - d;
            mu[qs] += d; st.l[qs] *= alpha; st.ls[qs] = st.ls[qs] * alpha;
#pragma unroll
            for (int ds = 0; ds < 4; ++ds) st.o[ds][qs] = st.o[ds][qs] * alpha;
        }
    }
#pragma unroll
    for (int qs = 0; qs < 2; ++qs) {
        const bool ok = qs ? ok1 : ok0;
        st.m[qs] = ok ? mu[qs] : st.m[qs];
#pragma unroll
        for (int ks = 0; ks < 4; ++ks)
#pragma unroll
            for (int r = 0; r < 4; ++r) s[ks][qs][r] = __builtin_amdgcn_exp2f(s[ks][qs][r]);
    }
    bf16x8 pf[2][2];
#pragma unroll
    for (int qs = 0; qs < 2; ++qs)
#pragma unroll
        for (int kp = 0; kp < 2; ++kp) {
            u32x4 t; t.x = pk2(s[2 * kp][qs][0], s[2 * kp][qs][1]); t.y = pk2(s[2 * kp][qs][2], s[2 * kp][qs][3]);
            t.z = pk2(s[2 * kp + 1][qs][0], s[2 * kp + 1][qs][1]); t.w = pk2(s[2 * kp + 1][qs][2], s[2 * kp + 1][qs][3]);
            pf[qs][kp] = __builtin_bit_cast(bf16x8, t);
        }
    const unsigned one2 = (fr == 0) ? 0x3F803F80u : 0u;
    const bf16x8 onesf = __builtin_bit_cast(bf16x8, (u32x4){one2, one2, one2, one2});
#pragma unroll
    for (int kp = 0; kp < 2; ++kp) {
        st.ls[0] = __builtin_amdgcn_mfma_f32_16x16x32_bf16(onesf, pf[0][kp], st.ls[0], 0, 0, 0);
        st.ls[1] = __builtin_amdgcn_mfma_f32_16x16x32_bf16(onesf, pf[1][kp], st.ls[1], 0, 0, 0);
    }
    __builtin_amdgcn_sched_barrier(0);
#pragma unroll
    for (int ds = 0; ds < 4; ++ds)
#pragma unroll
        for (int kp = 0; kp < 2; ++kp) {
            const v4i16_t lo = __builtin_amdgcn_ds_read_tr16_b64_v4i16((LAS v4i16_t*)(Vs + (32 * kp + 4 * q + (fr >> 2)) * AT_LD + 16 * ds + 4 * (fr & 3)));
            const v4i16_t hi = __builtin_amdgcn_ds_read_tr16_b64_v4i16((LAS v4i16_t*)(Vs + (32 * kp + 16 + 4 * q + (fr >> 2)) * AT_LD + 16 * ds + 4 * (fr & 3)));
            const bf16x8 vf = __builtin_shufflevector(lo, hi, 0, 1, 2, 3, 4, 5, 6, 7);
            st.o[ds][0] = __builtin_amdgcn_mfma_f32_16x16x32_bf16(vf, pf[0][kp], st.o[ds][0], 0, 0, 0);
            st.o[ds][1] = __builtin_amdgcn_mfma_f32_16x16x32_bf16(vf, pf[1][kp], st.o[ds][1], 0, 0, 0);
        }
    __builtin_amdgcn_sched_barrier(0);
}
__device__ __forceinline__ void attn_init(AttnAcc& st) {
#pragma unroll
    for (int ds = 0; ds < 4; ++ds) { st.o[ds][0] = (f32x4){0.f, 0.f, 0.f, 0.f}; st.o[ds][1] = (f32x4){0.f, 0.f, 0.f, 0.f}; }
    st.m[0] = st.m[1] = -1e30f; st.l[0] = st.l[1] = 0.f; st.ls[0] = st.ls[1] = (f32x4){0.f, 0.f, 0.f, 0.f};
}
__device__ __forceinline__ float quad_sum(float v) { v += __shfl_xor(v, 16); v += __shfl_xor(v, 32); return v; }
__device__ __forceinline__ float attn_rowsum(const AttnAcc& st, int qs) { return quad_sum(st.l[qs] + ((st.ls[qs][0] + st.ls[qs][1]) + (st.ls[qs][2] + st.ls[qs][3]))); }

__device__ __forceinline__ void banded_tile(AttnAcc& st, const bf16x8 (&qf)[2][2], LAS unsigned char* lds, int slot, int kt, int i, int window, int qtok0, int lane) {
    if (kt < i && (64 * i + 63 - 64 * kt) < window) { attn_tile_fast(st, qf, AT_KBUF(lds, slot), AT_VBUF(lds, slot), true, true, lane); return; }
    f32x4 s[4][2];
    qk_tile(AT_KBUF(lds, slot), qf, s, lane);
    softmax_tile(s, st, lane, kt * 64, qtok0, [window](int qt, int key) { const int d = qt - key; return d >= 0 && d < window; }, true);
    pv_tile(AT_VBUF(lds, slot), s, st.o, lane);
}
__device__ __forceinline__ void banded_attn(AttnAcc& st, const bf16x8 (&qf)[2][2], const bf16* __restrict__ Kb, const bf16* __restrict__ Vb,
                                            int i, int ntile_back, int window, int qtok0, LAS unsigned char* lds, int tid) {
    const int lane = tid & 63;
    const int kt0 = (i - ntile_back) > 0 ? (i - ntile_back) : 0;
    u32x4 rk, rv;
    rk = tile_fetch(Kb + (size_t)kt0 * 4096, tid); rv = tile_fetch(Vb + (size_t)kt0 * 4096, tid);
    tile_commit(AT_KBUF(lds, 0), rk, tid); tile_commit(AT_VBUF(lds, 0), rv, tid);
    if (kt0 + 1 <= i) { rk = tile_fetch(Kb + (size_t)(kt0 + 1) * 4096, tid); rv = tile_fetch(Vb + (size_t)(kt0 + 1) * 4096, tid);
                        tile_commit(AT_KBUF(lds, 1), rk, tid); tile_commit(AT_VBUF(lds, 1), rv, tid); }
    __syncthreads();
    for (int kt = kt0, buf = 0; kt <= i; kt += 2, buf ^= 1) {
        const bool n0 = kt + 2 <= i, n1 = kt + 3 <= i;
        if (n0) { rk = tile_fetch(Kb + (size_t)(kt + 2) * 4096, tid); rv = tile_fetch(Vb + (size_t)(kt + 2) * 4096, tid); }
        banded_tile(st, qf, lds, 2 * buf, kt, i, window, qtok0, lane);
        if (n0) { tile_commit(AT_KBUF(lds, 2 * (buf ^ 1)), rk, tid); tile_commit(AT_VBUF(lds, 2 * (buf ^ 1)), rv, tid); }
        if (n1) { rk = tile_fetch(Kb + (size_t)(kt + 3) * 4096, tid); rv = tile_fetch(Vb + (size_t)(kt + 3) * 4096, tid); }
        if (kt + 1 <= i) banded_tile(st, qf, lds, 2 * buf + 1, kt + 1, i, window, qtok0, lane);
        if (n1) { tile_commit(AT_KBUF(lds, 2 * (buf ^ 1) + 1), rk, tid); tile_commit(AT_VBUF(lds, 2 * (buf ^ 1) + 1), rv, tid); }
        __syncthreads();
    }
}

__device__ __forceinline__ void store_mixed(bf16* __restrict__ MIX, const f32x4 (&o)[4][2], int b, int t0w, int col0, int lane) {
    const int fr = lane & 15, q = lane >> 4;
#pragma unroll
    for (int qs = 0; qs < 2; ++qs) {
        const size_t row = (size_t)b * T + t0w + 16 * qs + fr;
#pragma unroll
        for (int ds = 0; ds < 4; ++ds) {
            u32x2 w; w.x = pk2(o[ds][qs][0], o[ds][qs][1]); w.y = pk2(o[ds][qs][2], o[ds][qs][3]);
            *(u32x2*)(MIX + row * D + col0 + 16 * ds + 4 * q) = w;
        }
    }
}

__device__ __forceinline__ void swa_unit(const Args& a, LAS unsigned char* lds, int tid, int b, int kvh, int i) {
    unsigned char* ws = a.ws;
    const int lane = tid & 63, w = tid >> 6, g = w >> 1, head = 4 * kvh + g, t0w = 64 * i + 32 * (w & 1);
    const bf16* Qh = (const bf16*)(ws + WS_Q) + ((size_t)(b * 16 + head) * T + t0w) * 64;
    const bf16* Kb = (const bf16*)(ws + WS_KV) + 0 * KV_TENSOR + (size_t)(b * 2 + kvh) * T * 64;
    const bf16* Vb = (const bf16*)(ws + WS_KV) + 1 * KV_TENSOR + (size_t)(b * 2 + kvh) * T * 64;
    bf16x8 qf[2][2]; load_qfrag(qf, Qh, lane);
    AttnAcc st; attn_init(st);
    const float sink = ((const float*)a.in[I_SINKS])[head];
    st.m[0] = st.m[1] = sink * 1.4426950408889634f; st.l[0] = st.l[1] = (lane < 16) ? 1.f : 0.f;
    banded_attn(st, qf, Kb, Vb, i, 2, 128, t0w, lds, tid);
#pragma unroll
    for (int qs = 0; qs < 2; ++qs) {
        const float inv = 1.0f / attn_rowsum(st, qs);
#pragma unroll
        for (int ds = 0; ds < 4; ++ds) st.o[ds][qs] = st.o[ds][qs] * inv;
    }
    store_mixed((bf16*)(ws + WS_MIXED), st.o, b, t0w, head * 64, lane);
}

__device__ __forceinline__ void nsa_unit(const Args& a, LAS unsigned char* lds, int tid, int b, int kvh, int i) {
    unsigned char* ws = a.ws;
    const int lane = tid & 63, w = tid >> 6, g = w >> 1, head = 4 * kvh + g, t0 = 64 * i, t0w = t0 + 32 * (w & 1), fr = lane & 15, q = lane >> 4;
    const int bh = b * 2 + kvh;
    LAS float* imp = (LAS float*)(lds + AT_IMP);
    LAS unsigned* selm = (LAS unsigned*)(lds + AT_SELM);
    const bf16* Qh = (const bf16*)(ws + WS_Q) + ((size_t)(b * 16 + 8 + head) * T + t0w) * 64;
    bf16x8 qf[2][2]; load_qfrag(qf, Qh, lane);
    const float* G = (const float*)(ws + WS_GATES);
    AttnAcc st;
    LAS float* OF = (LAS float*)(lds + AT_IMP) + w * 2048;

    const bf16* KC = (const bf16*)(ws + WS_KCMP) + (size_t)bh * 256 * 64;
    const bf16* VC = (const bf16*)(ws + WS_VCMP) + (size_t)bh * 256 * 64;
    const int cmax = (t0 + 63 - 31) >> 4, nct = cmax / 64 + 1;
    auto vis = [](int qt, int c) { return 16 * c + 31 <= qt; };
    u32x4 rk, rv;
    {
        u32x4 rkc[4], rvc[4];
#pragma unroll
        for (int ct = 0; ct < 4; ++ct) if (ct < nct) { rkc[ct] = tile_fetch(KC + (size_t)ct * 4096, tid); rvc[ct] = tile_fetch(VC + (size_t)ct * 4096, tid); }
#pragma unroll
        for (int ct = 0; ct < 4; ++ct) if (ct < nct) { tile_commit(AT_KBUF(lds, ct), rkc[ct], tid); tile_commit(AT_VBUF(lds, ct), rvc[ct], tid); }
    }
    __syncthreads();
    attn_init(st);
    for (int ct = 0; ct < nct; ++ct) {
        f32x4 s[4][2];
        qk_tile(AT_KBUF(lds, ct), qf, s, lane);
        softmax_tile(s, st, lane, ct * 64, t0w, vis, false);
    }
    float linv[2];
#pragma unroll
    for (int qs = 0; qs < 2; ++qs) { const float l = quad_sum(st.l[qs]); linv[qs] = l > 0.f ? 1.0f / l : 0.f; }
    float carry[2] = {0.f, 0.f};
    for (int ct = 0; ct < nct; ++ct) {
        f32x4 s[4][2];
        qk_tile(AT_KBUF(lds, ct), qf, s, lane);
#pragma unroll
        for (int qs = 0; qs < 2; ++qs) {
            const int qtok = t0w + 16 * qs + fr;
#pragma unroll
            for (int ks = 0; ks < 4; ++ks)
#pragma unroll
                for (int r = 0; r < 4; ++r) {
                    const int c = ct * 64 + 16 * ks + 4 * q + r;
                    s[ks][qs][r] = vis(qtok, c) ? __builtin_amdgcn_exp2f(s[ks][qs][r] - st.m[qs]) * linv[qs] : 0.f;
                }
            const int tokl = 32 * (w & 1) + 16 * qs + fr;
#pragma unroll
            for (int ks = 0; ks < 4; ++ks) {
                const float p3 = s[ks][qs][3];
                const float fromq = __shfl(p3, (lane + 48) & 63);
                const float prevk = (ks == 0) ? carry[qs] : s[ks > 0 ? ks - 1 : 0][qs][3];
                const float fromk = __shfl(prevk, (lane + 48) & 63);
                const float prev = (q > 0) ? fromq : fromk;
                const int j = ct * 16 + 4 * ks + q;
                imp[(g * 64 + tokl) * 64 + j] = (s[ks][qs][0] + s[ks][qs][1]) + (s[ks][qs][2] + 0.5f * p3) + 0.5f * prev;
            }
            carry[qs] = s[3][qs][3];
        }
        pv_tile(AT_VBUF(lds, ct), s, st.o, lane);
    }
    __syncthreads();
    {
        const int cur = i, j = lane;
        const bool valid = j <= cur, forced = (j == 0) || (j == cur) || (j == cur - 1);
        unsigned key[8], srt[8];
#pragma unroll
        for (int tt = 0; tt < 8; ++tt) {
            const int tokl = 8 * w + tt;
            unsigned k_ = 0u;
            if (valid && !forced) { const float sc = (imp[(0 * 64 + tokl) * 64 + j] + imp[(1 * 64 + tokl) * 64 + j]) + (imp[(2 * 64 + tokl) * 64 + j] + imp[(3 * 64 + tokl) * 64 + j]);
                                    k_ = ((__float_as_uint(sc) | 0x80000000u) & 0xFFFFFFC0u) | (unsigned)(63 - j); }
            if (valid && forced) k_ = 0xFFFFFFC0u | (unsigned)(63 - j);
            key[tt] = k_; srt[tt] = k_;
        }
#pragma unroll
        for (int k = 2; k <= 64; k <<= 1)
#pragma unroll
            for (int jj = k >> 1; jj >= 1; jj >>= 1) {
                const bool keepmax = ((lane & jj) == 0) == ((lane & k) == 0);
#pragma unroll
                for (int tt = 0; tt < 8; ++tt) {
                    const unsigned o = (unsigned)__shfl_xor((int)srt[tt], jj);
                    const unsigned mx = __builtin_elementwise_max(srt[tt], o), mn = __builtin_elementwise_min(srt[tt], o);
                    srt[tt] = keepmax ? mx : mn;
                }
            }
#pragma unroll
        for (int tt = 0; tt < 8; ++tt) {
            const unsigned thr = (unsigned)__builtin_amdgcn_readlane((int)srt[tt], 15);
            const bool sel = (key[tt] >= thr) && (key[tt] != 0u);
            const unsigned long long bm = __ballot(sel);
            if (lane == 0) { selm[(8 * w + tt) * 2] = (unsigned)bm; selm[(8 * w + tt) * 2 + 1] = (unsigned)(bm >> 32); }
        }
    }
    __syncthreads();
    unsigned long long uni;
    {
        unsigned lo = selm[lane * 2], hi = selm[lane * 2 + 1];
#pragma unroll
        for (int o = 1; o < 64; o <<= 1) { lo |= __shfl_xor(lo, o); hi |= __shfl_xor(hi, o); }
        uni = ((unsigned long long)(unsigned)__builtin_amdgcn_readfirstlane((int)hi) << 32) | (unsigned)__builtin_amdgcn_readfirstlane((int)lo);
    }
    unsigned long long qm[2];
#pragma unroll
    for (int qs = 0; qs < 2; ++qs) { const int tokl = 32 * (w & 1) + 16 * qs + fr; qm[qs] = ((unsigned long long)selm[tokl * 2 + 1] << 32) | selm[tokl * 2]; }
    __syncthreads();
#pragma unroll
    for (int qs = 0; qs < 2; ++qs) {
        const float g0 = G[((size_t)b * T + t0w + 16 * qs + fr) * 24 + head * 3 + 0];
#pragma unroll
        for (int ds = 0; ds < 4; ++ds)
#pragma unroll
            for (int r = 0; r < 4; ++r) OF[((ds * 2 + qs) * 4 + r) * 64 + lane] = st.o[ds][qs][r] * g0;
    }

    {
        const bf16* Kb = (const bf16*)(ws + WS_KV) + 4 * KV_TENSOR + (size_t)bh * T * 64;
        const bf16* Vb = (const bf16*)(ws + WS_KV) + 5 * KV_TENSOR + (size_t)bh * T * 64;
        attn_init(st);
        unsigned long long rem = uni;
        const int tbase = t0w + fr;
#define sel_tile(slot, j) { const unsigned b0 = (unsigned)((qm[0] >> (j)) & 1ull), b1 = (unsigned)((qm[1] >> (j)) & 1ull); \
            if ((j) < i) attn_tile_fast(st, qf, AT_KBUF(lds, slot), AT_VBUF(lds, slot), b0 != 0u, b1 != 0u, lane); \
            else { f32x4 s[4][2]; qk_tile(AT_KBUF(lds, slot), qf, s, lane); \
                   softmax_tile(s, st, lane, (j) * 64, t0w, [b0, b1, tbase](int qt, int key) { const unsigned bit = (qt - tbase) >= 16 ? b1 : b0; return bit != 0u && key <= qt; }, true); \
                   pv_tile(AT_VBUF(lds, slot), s, st.o, lane); } }
        int j0 = (int)__builtin_ctzll(rem); rem &= rem - 1;
        int j1 = rem ? (int)__builtin_ctzll(rem) : -1; if (j1 >= 0) rem &= rem - 1;
        rk = tile_fetch(Kb + (size_t)j0 * 4096, tid); rv = tile_fetch(Vb + (size_t)j0 * 4096, tid);
        tile_commit(AT_KBUF(lds, 0), rk, tid); tile_commit(AT_VBUF(lds, 0), rv, tid);
        if (j1 >= 0) { rk = tile_fetch(Kb + (size_t)j1 * 4096, tid); rv = tile_fetch(Vb + (size_t)j1 * 4096, tid);
                       tile_commit(AT_KBUF(lds, 1), rk, tid); tile_commit(AT_VBUF(lds, 1), rv, tid); }
        __syncthreads();
        for (int buf = 0;; buf ^= 1) {
            const int n0 = rem ? (int)__builtin_ctzll(rem) : -1; if (n0 >= 0) rem &= rem - 1;
            const int n1 = rem ? (int)__builtin_ctzll(rem) : -1; if (n1 >= 0) rem &= rem - 1;
            if (n0 >= 0) { rk = tile_fetch(Kb + (size_t)n0 * 4096, tid); rv = tile_fetch(Vb + (size_t)n0 * 4096, tid); }
            sel_tile(2 * buf, j0)
            if (n0 >= 0) { tile_commit(AT_KBUF(lds, 2 * (buf ^ 1)), rk, tid); tile_commit(AT_VBUF(lds, 2 * (buf ^ 1)), rv, tid); }
            if (n1 >= 0) { rk = tile_fetch(Kb + (size_t)n1 * 4096, tid); rv = tile_fetch(Vb + (size_t)n1 * 4096, tid); }
            if (j1 >= 0) sel_tile(2 * buf + 1, j1)
            if (n1 >= 0) { tile_commit(AT_KBUF(lds, 2 * (buf ^ 1) + 1), rk, tid); tile_commit(AT_VBUF(lds, 2 * (buf ^ 1) + 1), rv, tid); }
            __syncthreads();
            if (n0 < 0) break;
            j0 = n0; j1 = n1;
        }
#undef sel_tile
#pragma unroll
        for (int qs = 0; qs < 2; ++qs) {
            const float g1 = G[((size_t)b * T + t0w + 16 * qs + fr) * 24 + head * 3 + 1];
            const float sc = g1 / attn_rowsum(st, qs);
#pragma unroll
            for (int ds = 0; ds < 4; ++ds)
#pragma unroll
                for (int r = 0; r < 4; ++r) OF[((ds * 2 + qs) * 4 + r) * 64 + lane] += st.o[ds][qs][r] * sc;
        }
    }
    {
        const bf16* Kb = (const bf16*)(ws + WS_KV) + 6 * KV_TENSOR + (size_t)bh * T * 64;
        const bf16* Vb = (const bf16*)(ws + WS_KV) + 7 * KV_TENSOR + (size_t)bh * T * 64;
        attn_init(st);
        banded_attn(st, qf, Kb, Vb, i, 8, 512, t0w, lds, tid);
#pragma unroll
        for (int qs = 0; qs < 2; ++qs) {
            const float g2 = G[((size_t)b * T + t0w + 16 * qs + fr) * 24 + head * 3 + 2];
            const float sc = g2 / attn_rowsum(st, qs);
#pragma unroll
            for (int ds = 0; ds < 4; ++ds)
#pragma unroll
                for (int r = 0; r < 4; ++r) st.o[ds][qs][r] = OF[((ds * 2 + qs) * 4 + r) * 64 + lane] + st.o[ds][qs][r] * sc;
        }
    }
    store_mixed((bf16*)(ws + WS_MIXED), st.o, b, t0w, 512 + head * 64, lane);
    __syncthreads();
}

__device__ __forceinline__ void phase4(const Args& a, LAS unsigned char* lds, int tid) {
    for (int u = blockIdx.x; u < 2048; u += gridDim.x) {
        if (u < 1024) {
            const int bh = u & 15, x = (u >> 4) & 15, r = u >> 8;
            const int i = (r == 0) ? x : (r == 1) ? 63 - x : (r == 2) ? 16 + x : 47 - x;
            nsa_unit(a, lds, tid, bh >> 1, bh & 1, i);
        } else {
            const int v = u - 1024, bh = v & 15, i = v >> 4;
            swa_unit(a, lds, tid, bh >> 1, bh & 1, i);
        }
    }
}

struct EpiOutProj {
    static constexpr bool PERM = false, AFTER_DRAIN = false;
    const float* X; bf16* XB; float* SSP; float* AMP;
    __device__ __forceinline__ void operator()(const f32x4 (&acc)[2][2][4][2], const pg8::Unit& u, int wr, int wc, int fr, int fq) const {
#pragma unroll
        for (int ai = 0; ai < 2; ++ai)
#pragma unroll
            for (int m = 0; m < 4; ++m) {
                const size_t row = (size_t)u.pm * 256 + 128 * ai + 64 * wr + 16 * m + fr;
                float ss = 0.f, am = 0.f;
#pragma unroll
                for (int bj = 0; bj < 2; ++bj)
#pragma unroll
                    for (int n = 0; n < 2; ++n) {
                        const size_t off = row * D + u.pn * 256 + 128 * bj + 32 * wc + 16 * n + 4 * fq;
                        const f32x4 v = *(const f32x4*)(X + off) + acc[ai][bj][m][n];
                        u32x2 o; o.x = pk2(v[0], v[1]); o.y = pk2(v[2], v[3]);
                        *(u32x2*)(XB + off) = o;
                        ss += (v[0] * v[0] + v[1] * v[1]) + (v[2] * v[2] + v[3] * v[3]);
                        am = fmaxf(am, fmaxf(fmaxf(fabsf(v[0]), fabsf(v[1])), fmaxf(fabsf(v[2]), fabsf(v[3]))));
                    }
                ss += __shfl_xor(ss, 16); ss += __shfl_xor(ss, 32);
                am = fmaxf(am, __shfl_xor(am, 16)); am = fmaxf(am, __shfl_xor(am, 32));
                if (fq == 0) { SSP[row * 16 + u.pn * 4 + wc] = ss; AMP[row * 16 + u.pn * 4 + wc] = am; }
            }
    }
};
__device__ __forceinline__ void phase5(const Args& a, LAS unsigned char* lds, int tid) {
    unsigned char* ws = a.ws;
    pg8::Gemm g{(const bf16*)(ws + WS_MIXED), (const bf16*)(ws + WS_WOUT_T), NTOK, D, D};
    pg8::StaticOrder S; S.init(NTOK, D, (int)gridDim.x, (int)blockIdx.x);
    EpiOutProj E{(const float*)a.in[I_X], (bf16*)(ws + WS_H), (float*)(ws + WS_SSP), (float*)(ws + WS_AMP)};
    pg8::gemm_phase<EpiOutProj, pg8::StaticOrder, true, true>(lds, g, S, E);
}

struct EpiPeerQ {
    static constexpr bool PERM = true, AFTER_DRAIN = false;
    bf16* PQ; const float* SSP; const float* AMP; float* R2; float* AMAX;
    __device__ __forceinline__ void operator()(const f32x4 (&acc)[2][2][4][2], const pg8::Unit& u, int wr, int wc, int fr, int fq) const {
#pragma unroll
        for (int ai = 0; ai < 2; ++ai)
#pragma unroll
            for (int m = 0; m < 4; ++m) {
                const size_t row = (size_t)u.pm * 256 + 128 * ai + 64 * wr + 16 * m + fr;
                const f32x4 p0 = *(const f32x4*)(SSP + row * 16), p1 = *(const f32x4*)(SSP + row * 16 + 4), p2 = *(const f32x4*)(SSP + row * 16 + 8), p3 = *(const f32x4*)(SSP + row * 16 + 12);
                const f32x4 ps = (p0 + p1) + (p2 + p3);
                const float r = rsqrtf(((ps[0] + ps[1]) + (ps[2] + ps[3])) * (1.0f / D) + RMS_EPS);
                if (u.pn == 0 && wc == 0 && fq == 0) {
                    const f32x4 a0 = *(const f32x4*)(AMP + row * 16), a1 = *(const f32x4*)(AMP + row * 16 + 4), a2 = *(const f32x4*)(AMP + row * 16 + 8), a3 = *(const f32x4*)(AMP + row * 16 + 12);
                    const f32x4 mm = __builtin_elementwise_max(__builtin_elementwise_max(a0, a1), __builtin_elementwise_max(a2, a3));
                    R2[row] = r; AMAX[row] = fmaxf(fmaxf(mm[0], mm[1]), fmaxf(mm[2], mm[3]));
                }
#pragma unroll
                for (int bj = 0; bj < 2; ++bj) {
                    const f32x4 v0 = acc[ai][bj][m][0] * r, v1 = acc[ai][bj][m][1] * r;
                    u32x4 w; w.x = pk2(v0[0], v0[1]); w.y = pk2(v0[2], v0[3]); w.z = pk2(v1[0], v1[1]); w.w = pk2(v1[2], v1[3]);
                    *(u32x4*)(PQ + row * 2048 + u.pn * 256 + 128 * bj + 32 * wc + 8 * fq) = w;
                }
            }
    }
};
__device__ __forceinline__ void phase6(const Args& a, LAS unsigned char* lds, int tid) {
    unsigned char* ws = a.ws;
    pg8::Gemm g{(const bf16*)(ws + WS_H), (const bf16*)(ws + WS_WQ_T), NTOK, 2048, D};
    pg8::StaticOrder S; S.init(NTOK, 2048, (int)gridDim.x, (int)blockIdx.x);
    EpiPeerQ E{(bf16*)(ws + WS_PEERQ), (const float*)(ws + WS_SSP), (const float*)(ws + WS_AMP), (float*)(ws + WS_R2), (float*)(ws + WS_AMAX)};
    pg8::gemm_phase<EpiPeerQ, pg8::StaticOrder, true, true>(lds, g, S, E);
}

constexpr int P7_KLD = 136;
constexpr int P7_SK = 0, P7_TL = 2 * 128 * P7_KLD * 2, P7_END = P7_TL + 512 * 32 * 4;
__device__ __forceinline__ unsigned ord_key(float f) { const unsigned u = __float_as_uint(f); return (u & 0x80000000u) ? ~u : (u | 0x80000000u); }
__device__ __forceinline__ float ord_val(unsigned k) { const unsigned u = (k & 0x80000000u) ? (k & 0x7fffffffu) : ~k; return __uint_as_float(u); }
__device__ __forceinline__ void ins16(unsigned (&list)[16], unsigned c) {
#pragma unroll
    for (int k = 0; k < 16; ++k) { const unsigned hi = __builtin_elementwise_max(list[k], c); c = __builtin_elementwise_min(list[k], c); list[k] = hi; }
}
#define P7_CE(v, i, l) { const unsigned a_ = v[i], b_ = v[l]; v[i] = __builtin_elementwise_max(a_, b_); v[l] = __builtin_elementwise_min(a_, b_); }
template <int N> __device__ __forceinline__ void bitonic_sort_desc(unsigned (&v)[N]) {
#pragma unroll
    for (int k = 2; k <= N; k <<= 1)
#pragma unroll
        for (int j = k >> 1; j > 0; j >>= 1)
#pragma unroll
            for (int i = 0; i < N; ++i) { const int l = i ^ j; if (l > i) { if ((i & k) == 0) P7_CE(v, i, l) else P7_CE(v, l, i) } }
}
template <int N> __device__ __forceinline__ void bitonic_merge_desc(unsigned (&v)[N]) {
#pragma unroll
    for (int j = N >> 1; j > 0; j >>= 1)
#pragma unroll
        for (int i = 0; i < N; ++i) { const int l = i ^ j; if (l > i) P7_CE(v, i, l) }
}
__device__ __forceinline__ void sort16_desc(unsigned (&v)[16]) { P7_CE(v, 0, 1) P7_CE(v, 2, 3) P7_CE(v, 0, 2) P7_CE(v, 1, 3) P7_CE(v, 1, 2) P7_CE(v, 4, 5) P7_CE(v, 6, 7) P7_CE(v, 4, 6) P7_CE(v, 5, 7) P7_CE(v, 5, 6) P7_CE(v, 0, 4) P7_CE(v, 2, 6) P7_CE(v, 2, 4) P7_CE(v, 1, 5) P7_CE(v, 3, 7) P7_CE(v, 3, 5) P7_CE(v, 1, 2) P7_CE(v, 3, 4) P7_CE(v, 5, 6) P7_CE(v, 8, 9) P7_CE(v, 10, 11) P7_CE(v, 8, 10) P7_CE(v, 9, 11) P7_CE(v, 9, 10) P7_CE(v, 12, 13) P7_CE(v, 14, 15) P7_CE(v, 12, 14) P7_CE(v, 13, 15) P7_CE(v, 13, 14) P7_CE(v, 8, 12) P7_CE(v, 10, 14) P7_CE(v, 10, 12) P7_CE(v, 9, 13) P7_CE(v, 11, 15) P7_CE(v, 11, 13) P7_CE(v, 9, 10) P7_CE(v, 11, 12) P7_CE(v, 13, 14) P7_CE(v, 0, 8) P7_CE(v, 4, 12) P7_CE(v, 4, 8) P7_CE(v, 2, 10) P7_CE(v, 6, 14) P7_CE(v, 6, 10) P7_CE(v, 2, 4) P7_CE(v, 6, 8) P7_CE(v, 10, 12) P7_CE(v, 1, 9) P7_CE(v, 5, 13) P7_CE(v, 5, 9) P7_CE(v, 3, 11) P7_CE(v, 7, 15) P7_CE(v, 7, 11) P7_CE(v, 3, 5) P7_CE(v, 7, 9) P7_CE(v, 11, 13) P7_CE(v, 1, 2) P7_CE(v, 3, 4) P7_CE(v, 5, 6) P7_CE(v, 7, 8) P7_CE(v, 9, 10) P7_CE(v, 11, 12) P7_CE(v, 13, 14) }
__device__ __forceinline__ void top16_desc(unsigned (&t)[16], const unsigned (&o)[16]) {
#pragma unroll
    for (int k = 0; k < 16; ++k) t[k] = __builtin_elementwise_max(t[k], o[15 - k]);
    bitonic_merge_desc<16>(t);
}
__device__ __forceinline__ void phase7(const Args& a, LAS unsigned char* lds, int tid) {
    unsigned char* ws = a.ws;
    const bf16* PQ = (const bf16*)(ws + WS_PEERQ); const bf16* SK = (const bf16*)(ws + WS_SUBK);
    unsigned short* EIDX = (unsigned short*)(ws + WS_EIDX); float* EG = (float*)(ws + WS_EGATE); float* ESDT = (float*)(ws + WS_ESDT);
    const float* ESD = (const float*)(ws + WS_ESD); const float* ESU = (const float*)(ws + WS_ESU);
    LAS bf16* skl = (LAS bf16*)(lds + P7_SK);
    const int lane = tid & 63, w = tid >> 6, fr = lane & 15, q = lane >> 4;
    LAS unsigned* tlw = (LAS unsigned*)(lds + P7_TL) + (size_t)tid * 32;
    {
        const int row = tid >> 1, hf = tid & 1;
#pragma unroll
        for (int c = 0; c < 8; ++c) *(LAS u32x4*)(skl + row * P7_KLD + hf * 64 + c * 8) = *(const u32x4*)(SK + (size_t)row * 128 + hf * 64 + c * 8);
    }
    __syncthreads();
    for (int it = blockIdx.x * 8 + w; it < (NTOK / 16) * 2; it += gridDim.x * 8) {
        const int tok0 = (it >> 1) * 16, quad = it & 1;
        unsigned t1k[16], t2k[16];
#pragma unroll
        for (int k = 0; k < 16; ++k) { t1k[k] = 0u; t2k[k] = 0u; }
        const bf16* qrow0 = PQ + (size_t)(tok0 + fr) * 2048 + (4 * quad) * 256 + 8 * q;
        bf16x8 qn[4];
#pragma unroll
        for (int kk = 0; kk < 4; ++kk) qn[kk] = *(const bf16x8*)(qrow0 + 32 * kk);
#pragma unroll 1
        for (int hh = 0; hh < 8; ++hh) {
            const int hq = hh >> 1, half = hh & 1;
            bf16x8 qf[4];
#pragma unroll
            for (int kk = 0; kk < 4; ++kk) qf[kk] = qn[kk];
            if (hh < 7) {
#pragma unroll
                for (int kk = 0; kk < 4; ++kk) qn[kk] = *(const bf16x8*)(qrow0 + (hh + 1) * 128 + 32 * kk);
            }
            {
                f32x4 acc[8];
#pragma unroll
                for (int n = 0; n < 8; ++n) acc[n] = (f32x4){0.f, 0.f, 0.f, 0.f};
#pragma unroll
                for (int kk = 0; kk < 4; ++kk)
#pragma unroll
                    for (int n = 0; n < 8; ++n) {
                        const bf16x8 kf = *(const LAS bf16x8*)(skl + (half * 128 + 16 * n + fr) * P7_KLD + 32 * kk + 8 * q);
                        acc[n] = __builtin_amdgcn_mfma_f32_16x16x32_bf16(kf, qf[kk], acc[n], 0, 0, 0);
                    }
                unsigned v[32];
#pragma unroll
                for (int n = 0; n < 8; ++n)
#pragma unroll
                    for (int r = 0; r < 4; ++r) v[4 * n + r] = (ord_key(acc[n][r]) & 0xFFFFFF80u) | (unsigned)(127 - (16 * n + 4 * q + r));
                unsigned t[16];
                {
                    unsigned u2[16];
#pragma unroll
                    for (int k = 0; k < 16; ++k) { t[k] = v[k]; u2[k] = v[16 + k]; }
                    sort16_desc(t); sort16_desc(u2); top16_desc(t, u2);
                }
#pragma unroll
                for (int rnd = 0; rnd < 2; ++rnd) {
                    unsigned o[16];
#pragma unroll
                    for (int k = 0; k < 16; ++k) o[k] = (unsigned)__shfl_xor((int)t[15 - k], rnd ? 32 : 16);
#pragma unroll
                    for (int k = 0; k < 16; ++k) t[k] = __builtin_elementwise_max(t[k], o[k]);
                    bitonic_merge_desc<16>(t);
                }
                if (q == hq) {
#pragma unroll
                    for (int k = 0; k < 16; ++k) { if (half == 0) t1k[k] = t[k]; else t2k[k] = t[k]; }
                }
            }
        }
#pragma unroll
        for (int k = 0; k < 16; ++k) { tlw[k] = t1k[k]; tlw[16 + k] = t2k[k]; }
        float t1[16], t2[16];
#pragma unroll
        for (int k = 0; k < 16; ++k) { t1[k] = ord_val(t1k[k] & 0xFFFFFF80u); t2[k] = ord_val(t2k[k] & 0xFFFFFF80u); }
#define P7_KEY(aa, bb) ((ord_key(t1[aa] + t2[bb]) & 0xFFFFFF00u) | (unsigned)(255 - ((aa) * 16 + (bb))))
        unsigned list[16], l1[16], s2[16], s3[16];
#pragma unroll
        for (int k = 0; k < 16; ++k) { list[k] = P7_KEY(0, k); l1[k] = k < 8 ? P7_KEY(1, k) : 0u; }
        top16_desc(list, l1);
        { int n = 0;
#pragma unroll
          for (int aa = 2; aa < 7; ++aa)
#pragma unroll
              for (int bb = 0; bb < 16; ++bb) if ((aa + 1) * (bb + 1) <= 16) s2[n++] = P7_KEY(aa, bb); }
        s3[0] = P7_KEY(7, 0); s3[1] = P7_KEY(7, 1);
#pragma unroll
        for (int aa = 8; aa < 16; ++aa) s3[aa - 6] = P7_KEY(aa, 0);
#pragma unroll
        for (int k = 10; k < 16; ++k) s3[k] = 0u;
        sort16_desc(s2); sort16_desc(s3);
        top16_desc(list, s2); top16_desc(list, s3);
#undef P7_KEY
        float vv[16]; float sum = 0.f;
        const float v0 = ord_val(list[0] & 0xFFFFFF00u);
#pragma unroll
        for (int k = 0; k < 16; ++k) { vv[k] = __expf(ord_val(list[k] & 0xFFFFFF00u) - v0); sum += vv[k]; }
        const float inv = 1.0f / sum;
        const size_t obase = (size_t)(tok0 + fr) * 128 + (4 * quad + q) * 16;
#pragma unroll
        for (int k = 0; k < 16; ++k) {
            const unsigned pos = 255u - (list[k] & 255u), aa = pos >> 4, bb = pos & 15u;
            const unsigned i1 = 127u - (tlw[aa] & 127u), i2 = 127u - (tlw[16 + bb] & 127u);
            const unsigned e = i1 * 128u + i2;
            EIDX[obase + k] = (unsigned short)e;
            EG[obase + k] = vv[k] * inv * ESU[e];
            ESDT[obase + k] = ESD[e];
        }
    }
}

__device__ __forceinline__ int dot16(const u32x4 a, const u32x4 b) {
    int s = __builtin_amdgcn_sdot4((int)a.x, (int)b.x, 0, false);
    s = __builtin_amdgcn_sdot4((int)a.y, (int)b.y, s, false);
    s = __builtin_amdgcn_sdot4((int)a.z, (int)b.z, s, false);
    s = __builtin_amdgcn_sdot4((int)a.w, (int)b.w, s, false);
    return s;
}
typedef float f32x2 __attribute__((ext_vector_type(2)));
__device__ __forceinline__ void up_fma2(f32x2 (&acc)[8], const u32x4 u, float c) {
    const f32x2 cc = {c, c};
    acc[0] += cc * (f32x2){(float)(u.x & 0xffu), (float)((u.x >> 8) & 0xffu)}; acc[1] += cc * (f32x2){(float)((u.x >> 16) & 0xffu), (float)(u.x >> 24)};
    acc[2] += cc * (f32x2){(float)(u.y & 0xffu), (float)((u.y >> 8) & 0xffu)}; acc[3] += cc * (f32x2){(float)((u.y >> 16) & 0xffu), (float)(u.y >> 24)};
    acc[4] += cc * (f32x2){(float)(u.z & 0xffu), (float)((u.z >> 8) & 0xffu)}; acc[5] += cc * (f32x2){(float)((u.z >> 16) & 0xffu), (float)(u.z >> 24)};
    acc[6] += cc * (f32x2){(float)(u.w & 0xffu), (float)((u.w >> 8) & 0xffu)}; acc[7] += cc * (f32x2){(float)((u.w >> 16) & 0xffu), (float)(u.w >> 24)};
}
struct SliceJob { int slice, rank, nloc; };
__device__ __forceinline__ void p8_load_e(unsigned (&e)[8], const unsigned short* __restrict__ EIDX, int tok, int g) {
    const u32x4 t0 = *(const u32x4*)(EIDX + (size_t)tok * 128 + g * 16), t1 = *(const u32x4*)(EIDX + (size_t)tok * 128 + g * 16 + 8);
    e[0] = t0.x; e[1] = t0.y; e[2] = t0.z; e[3] = t0.w; e[4] = t1.x; e[5] = t1.y; e[6] = t1.z; e[7] = t1.w;
}
#define P8_EID(e, s) (((s) & 1) ? ((e)[(s) >> 1] >> 16) : ((e)[(s) >> 1] & 0xffffu))
typedef int i32x4 __attribute__((ext_vector_type(4)));
__device__ __forceinline__ void phase8a(const Args& a, LAS unsigned char* lds, int tid, const SliceJob jb_) {
    unsigned char* ws = a.ws;
    const SliceJob jb{__builtin_amdgcn_readfirstlane(jb_.slice), __builtin_amdgcn_readfirstlane(jb_.rank), __builtin_amdgcn_readfirstlane(jb_.nloc)};
    const unsigned char* EDT = ws + WS_EDOWN + (size_t)jb.slice * 16384 * 128;
    const bf16* XB = (const bf16*)(ws + WS_H) + jb.slice * 256;
    int* P = (int*)(ws + WS_PPART) + (size_t)jb.slice * NTOK * 128;
    const int lane = tid & 63, w = __builtin_amdgcn_readfirstlane(tid >> 6), g = lane >> 3, i = lane & 7, st = jb.nloc * 8;
    LAS unsigned char* scr = lds + w * 1024;
    LAS unsigned char* red = lds + 8192 + w * 4608 + g * 544 + i * 4;
    LAS unsigned char* redr = lds + 8192 + w * 4608 + g * 544 + i * 64;
    float gq[4];
    { const f32x4 nf = *(const f32x4*)((const float*)a.in[I_NORM_FFN] + jb.slice * 256 + 4 * lane); const float k = 119.0f / *(const float*)(ws + WS_GMAX); gq[0] = nf[0] * k; gq[1] = nf[1] * k; gq[2] = nf[2] * k; gq[3] = nf[3] * k; }
    const unsigned char* abase = lane < 32 ? ws + WS_EIDX + lane * 8 : ws + WS_AMAX;
    const unsigned astride = lane < 32 ? 256u : 4u;
#define P8A_AUX(ax, tok) ax = *(const u32x2*)(abase + (size_t)(unsigned)(tok) * astride);
#define P8A_GATHER(d, hx, am, ax, tok) { *(LAS u32x2*)(scr + lane * 8) = ax; \
        asm volatile("s_waitcnt lgkmcnt(0)" ::: "memory"); \
        unsigned e[8]; { const u32x4 t0 = *(const LAS u32x4*)(scr + g * 32), t1 = *(const LAS u32x4*)(scr + g * 32 + 16); e[0] = t0.x; e[1] = t0.y; e[2] = t0.z; e[3] = t0.w; e[4] = t1.x; e[5] = t1.y; e[6] = t1.z; e[7] = t1.w; } \
        am = *(const LAS float*)(scr + 256); \
        _Pragma("unroll") for (int j = 0; j < 16; ++j) d[j] = *(const u32x4*)(EDT + (unsigned)(P8_EID(e, j) * 128u + i * 16)); \
        hx = *(const u32x2*)(XB + (size_t)(tok) * D + 4 * lane); }
#define P8A_STEP(d, hx, am, ax, tok) { const int tk = tok; u32x4 hA, hB; { const float ia = 1.0f / fmaxf(am, 1e-30f); \
            const int g0 = (int)rintf(__uint_as_float(hx.x << 16) * gq[0] * ia), g1 = (int)rintf(__uint_as_float(hx.x & 0xffff0000u) * gq[1] * ia); \
            const int g2 = (int)rintf(__uint_as_float(hx.y << 16) * gq[2] * ia), g3 = (int)rintf(__uint_as_float(hx.y & 0xffff0000u) * gq[3] * ia); \
              \
            const int h0 = min(max(g0, -119), 119), h1 = min(max(g1, -119), 119), h2 = min(max(g2, -119), 119), h3 = min(max(g3, -119), 119); \
            const int a0 = (h0 + 8) >> 4, a1 = (h1 + 8) >> 4, a2 = (h2 + 8) >> 4, a3 = (h3 + 8) >> 4; \
            const unsigned A16 = (unsigned)(a0 & 15) | ((unsigned)(a1 & 15) << 4) | ((unsigned)(a2 & 15) << 8) | ((unsigned)(a3 & 15) << 12); \
            const unsigned B16 = (unsigned)((h0 - 16 * a0) & 15) | ((unsigned)((h1 - 16 * a1) & 15) << 4) | ((unsigned)((h2 - 16 * a2) & 15) << 8) | ((unsigned)((h3 - 16 * a3) & 15) << 12); \
            *(LAS unsigned short*)(scr + 512 + g * 32 + 2 * i) = (unsigned short)A16; *(LAS unsigned short*)(scr + 512 + g * 32 + 16 + 2 * i) = (unsigned short)B16; \
            asm volatile("s_waitcnt lgkmcnt(0)" ::: "memory");     \
            hA = *(const LAS u32x4*)(scr + 512 + i * 32); hB = *(const LAS u32x4*)(scr + 512 + i * 32 + 16); } \
        int v[16]; _Pragma("unroll") for (int j = 0; j < 16; ++j) { int sa = 0, sb = 0; \
            _Pragma("unroll") for (int p = 0; p < 4; ++p) { sa = __builtin_amdgcn_sdot8((int)d[j][p], (int)hA[p], sa, false); sb = __builtin_amdgcn_sdot8((int)d[j][p], (int)hB[p], sb, false); } \
            v[j] = sa * 16 + sb; } \
        P8A_GATHER(d, hx, am, ax, min(tk + 2 * st, NTOK - 1)) P8A_AUX(ax, min(tk + 4 * st, NTOK - 1)) \
          \
        _Pragma("unroll") for (int j = 0; j < 16; ++j) *(LAS int*)(red + j * 32) = v[j]; \
        int v2[2]; { const i32x4 q0 = *(const LAS i32x4*)(redr), q1 = *(const LAS i32x4*)(redr + 16), q2 = *(const LAS i32x4*)(redr + 32), q3 = *(const LAS i32x4*)(redr + 48); \
            const i32x4 s0 = q0 + q1, s1 = q2 + q3; v2[0] = (s0[0] + s0[1]) + (s0[2] + s0[3]); v2[1] = (s1[0] + s1[1]) + (s1[2] + s1[3]); } \
        u32x2 o; o.x = (unsigned)v2[0]; o.y = (unsigned)v2[1]; *(u32x2*)(P + (size_t)tk * 128 + g * 16 + 2 * i) = o; }
    int tokA = jb.rank * 8 + w, tokB = tokA + st;
    if (tokA >= NTOK) return;
    u32x4 dA[16], dB[16]; u32x2 hxA, hxB, axA, axB; float amA, amB;
    P8A_AUX(axA, tokA)
    P8A_AUX(axB, min(tokB, NTOK - 1))
    P8A_GATHER(dA, hxA, amA, axA, tokA)
    P8A_AUX(axA, min(tokA + 2 * st, NTOK - 1))
    P8A_GATHER(dB, hxB, amB, axB, min(tokB, NTOK - 1))
    P8A_AUX(axB, min(tokB + 2 * st, NTOK - 1))
    for (int np = ((NTOK - 1 - tokA) / st + 2) >> 1; np > 0; --np) {
        P8A_STEP(dA, hxA, amA, axA, min(tokA, NTOK - 1))
        P8A_STEP(dB, hxB, amB, axB, min(tokB, NTOK - 1))
        tokA += 2 * st; tokB += 2 * st;
    }
#undef P8A_AUX
#undef P8A_GATHER
#undef P8A_STEP
}
__device__ __forceinline__ void phase8b(const Args& a, int tid) {
    unsigned char* ws = a.ws;
    const int* P = (const int*)(ws + WS_PPART); const float* EG = (const float*)(ws + WS_EGATE); const float* ESDT = (const float*)(ws + WS_ESDT);
    const float* R2 = (const float*)(ws + WS_R2); const float* AMAX = (const float*)(ws + WS_AMAX); float* CSC = (float*)(ws + WS_CSC); unsigned char* CQ = ws + WS_COEFQ;
    const float gmax127 = *(const float*)(ws + WS_GMAX) * (1.0f / 119.0f);
    const int lane = tid & 63, stp = gridDim.x * 8;
    int tok = blockIdx.x * 8 + (tid >> 6);
    if (tok >= NTOK) return;
    typedef int i32x2_t __attribute__((ext_vector_type(2)));
    i32x2_t p[4], np[4]; f32x2 eg, sd, neg, nsd; float am, r2, nam, nr2;
#define P8B_LOAD(p, eg, sd, am, r2, t) { _Pragma("unroll") for (int x = 0; x < 4; ++x) p[x] = *(const i32x2_t*)(P + ((size_t)x * NTOK + (t)) * 128 + 2 * lane); \
        eg = *(const f32x2*)(EG + (size_t)(t) * 128 + 2 * lane); sd = *(const f32x2*)(ESDT + (size_t)(t) * 128 + 2 * lane); am = AMAX[t]; r2 = R2[t]; }
    P8B_LOAD(p, eg, sd, am, r2, tok)
    for (; tok < NTOK; tok += stp) {
        const int tn = min(tok + stp, NTOK - 1);
        P8B_LOAD(np, neg, nsd, nam, nr2, tn)
        const i32x2_t sm = (p[0] + p[1]) + (p[2] + p[3]);
        const float sh = am * r2 * gmax127;
        const float c0 = eg.x * gelu_erf((float)sm.x * sh * sd.x), c1 = eg.y * gelu_erf((float)sm.y * sh * sd.y);
        float cm = fmaxf(fabsf(c0), fabsf(c1));
#pragma unroll
        for (int x = 1; x < 64; x <<= 1) cm = fmaxf(cm, __shfl_xor(cm, x));
        cm = fmaxf(cm, 1e-30f);
        const float qi = 127.0f / cm;
        const int q0 = (int)rintf(c0 * qi), q1 = (int)rintf(c1 * qi);
        { const int r0 = 64 * ((lane >> 2) & 1) + 16 * (lane & 3) + (lane >> 3); CQ[(size_t)tok * 128 + r0] = (unsigned char)q0; CQ[(size_t)tok * 128 + r0 + 8] = (unsigned char)q1; }
        int qs = q0 + q1;
#pragma unroll
        for (int x = 1; x < 64; x <<= 1) qs += __shfl_xor(qs, x);
        if (lane == 0) { u32x2 o; o.x = __float_as_uint(cm * (1.0f / 127.0f)); o.y = (unsigned)qs; *(u32x2*)(CSC + 2 * (size_t)tok) = o; }
#pragma unroll
        for (int x = 0; x < 4; ++x) p[x] = np[x];
        eg = neg; sd = nsd; am = nam; r2 = nr2;
    }
#undef P8B_LOAD
}
typedef int v2i32_t __attribute__((ext_vector_type(2)));
typedef int i32x4 __attribute__((ext_vector_type(4)));
__device__ __forceinline__ void phase8c(const Args& a, LAS unsigned char* lds, int tid, const SliceJob jb_) {
    unsigned char* ws = a.ws;
    const SliceJob jb{__builtin_amdgcn_readfirstlane(jb_.slice), __builtin_amdgcn_readfirstlane(jb_.rank), __builtin_amdgcn_readfirstlane(jb_.nloc)};
    const unsigned char* EUT = ws + WS_EUP + (size_t)jb.slice * 16384 * 128;
    const bf16* XBs = (const bf16*)(ws + WS_H) + jb.slice * 256; bf16* X2 = (bf16*)(ws + WS_MIXED);
    const int lane = tid & 63, w = __builtin_amdgcn_readfirstlane(tid >> 6), g = lane >> 3, i = lane & 7, fr = lane & 15, q = lane >> 4, st = jb.nloc * 8;
    LAS unsigned char* img = lds + w * 16384;
    LAS unsigned char* scr = lds + 131072 + w * 2048;
    LAS unsigned char* rbase = img + (16 * q + (fr >> 1)) * 128 + 8 * (fr & 1);
    const int F = ((fr >> 2) & 3) | ((q & 1) << 2);
    const unsigned sc0 = 16u * (unsigned)(i ^ ((g >> 1) & 3)), sc1 = sc0 ^ 64u;
    const unsigned rbase32 = (unsigned)(__UINTPTR_TYPE__)rbase, img32 = (unsigned)(__UINTPTR_TYPE__)img, scr32 = (unsigned)(__UINTPTR_TYPE__)scr;
    const unsigned char* bbase = lane < 32 ? ws + WS_COEFQ + lane * 4 : ws + WS_CSC + 4 * min(lane - 32, 1);
    const unsigned bstride = lane < 32 ? 128u : 8u, l4 = (unsigned)lane * 4u;
    const i32x4 NIB = (i32x4){0x0f0f0f0f, 0x0f0f0f0f, 0x0f0f0f0f, 0x0f0f0f0f};
#define P8C_AUXDMA(par, tok) { const unsigned char* s_ = ws + WS_EIDX + (size_t)(unsigned)(tok) * 256u; const unsigned char* p_ = bbase + (size_t)(unsigned)(tok) * bstride; \
        asm volatile("s_mov_b32 m0, %0\n\ts_nop 0\n\tglobal_load_lds_dword %1, %2" :: "s"(scr32 + (unsigned)(par) * 1024u), "v"(l4), "s"(s_) : "memory"); \
        asm volatile("s_mov_b32 m0, %0\n\ts_nop 0\n\tglobal_load_lds_dword %1, off" :: "s"(scr32 + (unsigned)(par) * 1024u + 256u), "v"(p_) : "memory"); }
#define P8C_XDMA(par, tok) { const unsigned char* s_ = (const unsigned char*)(XBs + (size_t)(tok) * D); \
        asm volatile("s_mov_b32 m0, %0\n\ts_nop 0\n\tglobal_load_lds_dword %1, %2" :: "s"(scr32 + (unsigned)(par) * 1024u + 512u), "v"(l4), "s"(s_) : "memory"); \
        asm volatile("s_mov_b32 m0, %0\n\ts_nop 0\n\tglobal_load_lds_dword %1, %2" :: "s"(scr32 + (unsigned)(par) * 1024u + 768u), "v"(l4), "s"(s_ + 256) : "memory"); }
#define P8C_SPREAD(e, c0, c1, cs, cz, par) { LAS unsigned char* ab = scr + (par) * 1024; \
        { const u32x4 t0 = *(const LAS u32x4*)(ab + g * 32), t1 = *(const LAS u32x4*)(ab + g * 32 + 16); e[0] = t0.x; e[1] = t0.y; e[2] = t0.z; e[3] = t0.w; e[4] = t1.x; e[5] = t1.y; e[6] = t1.z; e[7] = t1.w; } \
        c0 = *(const LAS i32x4*)(ab + 256 + 16 * q); c1 = *(const LAS i32x4*)(ab + 320 + 16 * q); cs = *(const LAS float*)(ab + 384); cz = *(const LAS int*)(ab + 388); }
#define P8C_DMA(h, e) { _Pragma("unroll") for (int jj = 0; jj < 8; ++jj) \
        asm volatile("s_mov_b32 m0, %0\n\ts_nop 0\n\tglobal_load_lds_dwordx4 %1, %2" :: "s"(img32 + (unsigned)((h) * 8192 + jj * 1024)), "v"((unsigned)(P8_EID(e, 8 * (h) + jj) * 128u + (((jj >> 1) & 1) ? sc1 : sc0))), "s"(EUT) : "memory"); }
#define P8C_RD(h, t, x0, x1) { const unsigned rb = rbase32 + 16u * (unsigned)((t) ^ F); \
        asm volatile("ds_read_b64_tr_b8 %0, %1 offset:%2" : "=v"(x0) : "v"(rb), "i"((h) * 8192)); asm volatile("ds_read_b64_tr_b8 %0, %1 offset:%2" : "=v"(x1) : "v"(rb), "i"((h) * 8192 + 1024)); }
#define P8C_WT(n, x0, x1) asm volatile("s_waitcnt lgkmcnt(" #n ")" : "+v"(x0), "+v"(x1));
#define P8C_MM(h, t, kk, x0, x1) { const i32x4 wv = (i32x4){x0[0], x0[1], x1[0], x1[1]}; \
        aL[t] = __builtin_amdgcn_mfma_i32_16x16x64_i8(kk, wv & NIB, (h) ? aL[t] : (i32x4){0, 0, 0, 0}, 0, 0, 0); aR[t] = __builtin_amdgcn_mfma_i32_16x16x64_i8(kk, wv, (h) ? aR[t] : (i32x4){0, 0, 0, 0}, 0, 0, 0); }
#define P8C_HALF(h, kk) { v2i32_t pa0, pa1, pb0, pb1, pc0, pc1; \
        P8C_RD(h, 0, pa0, pa1) P8C_RD(h, 1, pb0, pb1) \
        P8C_RD(h, 2, pc0, pc1) P8C_WT(4, pa0, pa1) P8C_MM(h, 0, kk, pa0, pa1) \
        P8C_RD(h, 3, pa0, pa1) P8C_WT(4, pb0, pb1) P8C_MM(h, 1, kk, pb0, pb1) \
        P8C_RD(h, 4, pb0, pb1) P8C_WT(4, pc0, pc1) P8C_MM(h, 2, kk, pc0, pc1) \
        P8C_RD(h, 5, pc0, pc1) P8C_WT(4, pa0, pa1) P8C_MM(h, 3, kk, pa0, pa1) \
        P8C_RD(h, 6, pa0, pa1) P8C_WT(4, pb0, pb1) P8C_MM(h, 4, kk, pb0, pb1) \
        P8C_RD(h, 7, pb0, pb1) P8C_WT(4, pc0, pc1) P8C_MM(h, 5, kk, pc0, pc1) \
        P8C_WT(2, pa0, pa1) P8C_MM(h, 6, kk, pa0, pa1) P8C_WT(0, pb0, pb1) P8C_MM(h, 7, kk, pb0, pb1) }
    int tok = jb.rank * 8 + w;
    if (tok >= NTOK) return;
    __builtin_amdgcn_s_waitcnt(0x0F70);
    unsigned e[8]; i32x4 c0, c1; float cs; int cz;
    P8C_AUXDMA(0, tok)
    asm volatile("s_waitcnt vmcnt(0)" ::: "memory");
    P8C_SPREAD(e, c0, c1, cs, cz, 0)
    asm volatile("" ::: "memory");
    P8C_XDMA(0, tok)
    P8C_AUXDMA(1, min(tok + st, NTOK - 1))
    P8C_DMA(0, e) P8C_DMA(1, e)
    int par = 0;
    for (int n = (NTOK - 1 - tok) / st + 1; n > 0; --n) {
        asm volatile("s_waitcnt vmcnt(8)" ::: "memory");
        const i32x4 k0 = c0, k1 = c1; const float ks = cs; const int kz = 8 * cz;
        i32x4 aL[8], aR[8];
        P8C_HALF(0, k0)
        P8C_SPREAD(e, c0, c1, cs, cz, par ^ 1)
        asm volatile("s_waitcnt lgkmcnt(0)" ::: "memory");
        P8C_AUXDMA(par, min(tok + 2 * st, NTOK - 1))
        P8C_XDMA(par ^ 1, min(tok + st, NTOK - 1))
        P8C_DMA(0, e)
        asm volatile("s_waitcnt vmcnt(12)" ::: "memory");
        P8C_HALF(1, k1)
        int r0 = aL[0][0], r1 = aR[0][0], r2 = aL[1][0], r3 = aR[1][0];
#pragma unroll
        for (int p = 1; p < 4; ++p) { r0 = (q == p) ? aL[2 * p][0] : r0; r1 = (q == p) ? aR[2 * p][0] : r1; r2 = (q == p) ? aL[2 * p + 1][0] : r2; r3 = (q == p) ? aR[2 * p + 1][0] : r3; }
        *(LAS v2i32_t*)(img + 8192 + (64 * q + 2 * fr) * 4) = (v2i32_t){r0, r1}; *(LAS v2i32_t*)(img + 8192 + (64 * q + 32 + 2 * fr) * 4) = (v2i32_t){r2, r3};
        asm volatile("s_waitcnt lgkmcnt(0)" ::: "memory");
        const i32x4 rr = *(const LAS i32x4*)(img + 8192 + lane * 16);
        const u32x2 yy = *(const LAS u32x2*)(scr + par * 1024 + 512 + lane * 8);
        { u32x2 o; o.x = pk2(__uint_as_float(yy.x << 16) + (float)(rr[0] - kz) * ks, __uint_as_float(yy.x & 0xffff0000u) + (float)((rr[1] - rr[0]) >> 4) * ks);
          o.y = pk2(__uint_as_float(yy.y << 16) + (float)(rr[2] - kz) * ks, __uint_as_float(yy.y & 0xffff0000u) + (float)((rr[3] - rr[2]) >> 4) * ks);
          bf16* p_ = X2 + (size_t)tok * D + jb.slice * 256 + 4 * lane; asm volatile("global_store_dwordx2 %0, %1, off" :: "v"(p_), "v"(o) : "memory"); }
        P8C_DMA(1, e)
        tok += st; par ^= 1;
    }
    asm volatile("s_waitcnt vmcnt(0)" ::: "memory");
#undef P8C_AUXDMA
#undef P8C_XDMA
#undef P8C_SPREAD
#undef P8C_DMA
#undef P8C_RD
#undef P8C_WT
#undef P8C_MM
#undef P8C_HALF
}
__device__ __forceinline__ void phase8d(const Args& a, int tid) {
    const float* NF = (const float*)a.in[I_NORM_F]; const bf16* X2 = (const bf16*)(a.ws + WS_MIXED);
    const int lane = tid & 63, stp = gridDim.x * 8;
    int tok = blockIdx.x * 8 + (tid >> 6);
    if (tok >= NTOK) return;
    u32x2 v[4], nx[4]; f32x4 nf[4];
#pragma unroll
    for (int j = 0; j < 4; ++j) { v[j] = *(const u32x2*)(X2 + (size_t)tok * D + (lane + 64 * j) * 4); nf[j] = *(const f32x4*)(NF + (lane + 64 * j) * 4); }
    for (; tok < NTOK; tok += stp) {
        const bf16* nrow = X2 + (size_t)min(tok + stp, NTOK - 1) * D;
#pragma unroll
        for (int j = 0; j < 4; ++j) nx[j] = *(const u32x2*)(nrow + (lane + 64 * j) * 4);
        float* row = a.out + (size_t)tok * D; float ss = 0.f; f32x4 f[4];
#pragma unroll
        for (int j = 0; j < 4; ++j) { f[j] = (f32x4){__uint_as_float(v[j].x << 16), __uint_as_float(v[j].x & 0xffff0000u), __uint_as_float(v[j].y << 16), __uint_as_float(v[j].y & 0xffff0000u)};
            ss += (f[j][0] * f[j][0] + f[j][1] * f[j][1]) + (f[j][2] * f[j][2] + f[j][3] * f[j][3]); }
        const float r = rsqrtf(wave_sum(ss) * (1.0f / D) + RMS_EPS);
#pragma unroll
        for (int j = 0; j < 4; ++j) *(f32x4*)(row + (lane + 64 * j) * 4) = f[j] * r * nf[j];
#pragma unroll
        for (int j = 0; j < 4; ++j) v[j] = nx[j];
    }
}

__device__ __forceinline__ int opaque(int v) { asm volatile("" : "+v"(v)); return v; }
__global__ void __launch_bounds__(512, 2) fwd(Args args) {
    extern __shared__ __attribute__((aligned(16))) unsigned char lds_raw[];
    LAS unsigned char* lds = (LAS unsigned char*)lds_raw;
    const int tid = threadIdx.x;
    if (tid < 4) ((LAS unsigned*)(lds + LDS_BARW))[tid] = 0u;
    __syncthreads();
    unsigned* barw = (unsigned*)(args.ws + WS_CTL);
    const unsigned my_xcc = xb_xcc_id();
    if (tid == 0) ((LAS int*)(lds + LDS_JOB))[3] = (MK_N_LAUNCHES == 1) ? (int)xb_add(&barw[CW_RANK + 64 * my_xcc], 1u) : 0;
    XcdBarrier bar; bar.bar = barw; bar.x = 0; bar.st = nullptr;
    const int lo = args.ph_lo, hi = args.ph_hi;
    if (MK_N_LAUNCHES == 1 || hi - lo > 1) bar = xcd_barrier_post(barw, (volatile LAS unsigned*)(lds + LDS_BARW));
#if MK_N_LAUNCHES == 1
#define IN(k) true
#else
#define IN(k) (lo <= (k) && (k) < hi)
#endif
#define SEAM(k) do { if (IN(k) && IN((k) + 1)) xcd_barrier(bar); } while (0)
    if (IN(0)) phase0(args, opaque(tid));
    SEAM(0);
    if (IN(1)) phase1(args, lds, opaque(tid));
    SEAM(1);
    if (IN(2)) phase2(args, lds, opaque(tid));
    SEAM(2);
    if (IN(3)) phase3(args, lds, opaque(tid));
    SEAM(3);
    if (IN(4)) phase4(args, lds, opaque(tid));
    SEAM(4);
    if (IN(5)) phase5(args, lds, opaque(tid));
    SEAM(5);
    if (IN(6)) phase6(args, lds, opaque(tid));
    SEAM(6);
    if (IN(7)) phase7(args, lds, opaque(tid));
    SEAM(7);
    SliceJob jb, jc;
    {
        LAS int* jw = (LAS int*)(lds + LDS_JOB);
        if (tid == 0) {
            int cnt[16]; bool ok8 = true;
#pragma unroll
            for (int j = 0; j < 16; ++j) { cnt[j] = (int)xb_ld(&barw[XB_XCNT(j)]); ok8 = ok8 && (j < 8 ? cnt[j] > 0 : cnt[j] == 0); }
            int mine = 0;
#pragma unroll
            for (int j = 0; j < 16; ++j) mine = (j == (int)my_xcc) ? cnt[j] : mine;
            const int my_rank = jw[3];
            int lower = 0, upper = 0;
#pragma unroll
            for (int j = 0; j < 16; ++j) { lower = (j == (int)(my_xcc & ~1u)) ? cnt[j] : lower; upper = (j == (int)(my_xcc | 1u)) ? cnt[j] : upper; }
            if (MK_N_LAUNCHES == 1 && ok8 && my_rank < mine) { jw[0] = (int)my_xcc; jw[1] = my_rank; jw[2] = mine;
                jw[4] = (int)(my_xcc >> 1); jw[5] = my_rank + ((my_xcc & 1u) ? lower : 0); jw[6] = lower + upper; }
            else { const int sl = blockIdx.x & 7, G = (int)gridDim.x; jw[0] = sl; jw[1] = blockIdx.x >> 3; jw[2] = (G + 7 - sl) >> 3;
                const int nlo = (G + 7 - (sl & ~1)) >> 3, nhi = (G + 7 - (sl | 1)) >> 3; jw[4] = sl >> 1; jw[5] = (blockIdx.x >> 3) + ((sl & 1) ? nlo : 0); jw[6] = nlo + nhi; }
        }
        __syncthreads();
        jb.slice = jw[0]; jb.rank = jw[1]; jb.nloc = jw[2]; jc.slice = jw[4]; jc.rank = jw[5]; jc.nloc = jw[6];
    }
    if (IN(8)) phase8a(args, lds, opaque(tid), jc);
    SEAM(8);
    if (IN(9)) phase8b(args, opaque(tid));
    SEAM(9);
    if (IN(10)) phase8c(args, lds, opaque(tid), jc);
    SEAM(10);
    if (IN(11)) phase8d(args, opaque(tid));
#undef IN
#undef SEAM
}

extern "C" void kernel_launch(void* const* d_in, const int* in_sizes, int n_in, void* d_out, int out_size, void* d_ws, size_t ws_size, hipStream_t stream) {
    static int grid = 0;
    if (grid == 0) {
        if (n_in != 19 || out_size != NTOK * D || ws_size < WS_END) {
            fprintf(stderr, "kernel_launch: unexpected shapes (n_in %d, out %d, ws %zu); nothing launched\n", n_in, out_size, ws_size); grid = -1; return; }
        int dev = 0, cus = 0;
        if (hipGetDevice(&dev) != hipSuccess || hipDeviceGetAttribute(&cus, hipDeviceAttributeMultiprocessorCount, dev) != hipSuccess) { grid = -1; return; }
        if (hipFuncSetAttribute((const void*)fwd, hipFuncAttributeMaxDynamicSharedMemorySize, LDS_BYTES) != hipSuccess) { fprintf(stderr, "kernel_launch: hipFuncSetAttribute failed\n"); grid = -1; return; }
        int per_cu = 0;
        if (hipOccupancyMaxActiveBlocksPerMultiprocessor(&per_cu, (const void*)fwd, 512, LDS_BYTES) != hipSuccess || per_cu < 1) { fprintf(stderr, "kernel_launch: occupancy query says %d blocks per CU\n", per_cu); (void)hipGetLastError(); }
        grid = cus;
    }
    if (grid < 0) return;
    (void)hipMemsetAsync((char*)d_ws + WS_CTL, 0, CTL_BYTES, stream);
    Args a{};
    for (int i = 0; i < 19; ++i) a.in[i] = d_in[i];
    a.out = (float*)d_out; a.ws = (unsigned char*)d_ws;
    if (MK_N_LAUNCHES == 1) {
        a.ph_lo = 0; a.ph_hi = NPHASE;
        hipLaunchKernelGGL(fwd, dim3(grid), dim3(512), LDS_BYTES, stream, a);
    } else {
        for (int p = 0; p < NPHASE; ++p) { a.ph_lo = p; a.ph_hi = p + 1; hipLaunchKernelGGL(fwd, dim3(grid), dim3(512), LDS_BYTES, stream, a); }
    }
}
```

```cpp
#include <hip/hip_runtime.h>
#include <cstdio>
#include <cstdint>

#ifndef MK_N_LAUNCHES
#define MK_N_LAUNCHES 1
#endif

#define LAS __attribute__((address_space(3)))
typedef unsigned short bf16;
typedef short bf16x8 __attribute__((ext_vector_type(8)));
typedef short bf16x4 __attribute__((ext_vector_type(4)));
typedef float f32x4 __attribute__((ext_vector_type(4)));
typedef unsigned u32x4 __attribute__((ext_vector_type(4)));
typedef unsigned u32x2 __attribute__((ext_vector_type(2)));

constexpr int NB = 8, T = 4096, D = 1024, NTOK = NB * T, HD = 64;
constexpr int INW = 2072, INW_PAD = 2176;
constexpr int NPHASE = 12;
constexpr float RMS_EPS = 1e-6f;

constexpr size_t MiB = 1u << 20;
constexpr size_t WS_CTL = 0, CTL_BYTES = 64 * 1024;
constexpr size_t WS_WIN_T = 2 * MiB;
constexpr size_t WS_WG_T = 6 * MiB;
constexpr size_t WS_WOUT_T = 8 * MiB;
constexpr size_t WS_WQ_T = 10 * MiB;
constexpr size_t WS_CW1_T = 14 * MiB;
constexpr size_t WS_CW2_T = 16 * MiB;
constexpr size_t WS_CB1 = 16 * MiB + 256 * 1024;
constexpr size_t WS_SUBK = 16 * MiB + 512 * 1024;
constexpr size_t WS_ROPE_C = 18 * MiB, WS_ROPE_S = 22 * MiB;
constexpr size_t WS_GATES = 26 * MiB;
constexpr size_t WS_CHID = 30 * MiB;
constexpr size_t WS_KCMP = 34 * MiB;
constexpr size_t WS_VCMP = 34 * MiB + 512 * 1024;
constexpr size_t WS_EDOWN = 36 * MiB, WS_EUP = 52 * MiB;
constexpr size_t WS_ESD = 68 * MiB, WS_ESU = 68 * MiB + 64 * 1024;
constexpr size_t WS_H = 100 * MiB;
constexpr size_t WS_MIXED = 164 * MiB;
constexpr size_t WS_Q = 228 * MiB;
constexpr size_t WS_KV = 292 * MiB;
constexpr size_t WS_PEERQ = 228 * MiB;
constexpr size_t WS_EIDX = 356 * MiB;
constexpr size_t WS_EGATE = 372 * MiB;
constexpr size_t WS_SSP = 420 * MiB;
constexpr size_t WS_ESDT = 422 * MiB;
constexpr size_t WS_H2S = 438 * MiB;
constexpr size_t WS_CSC = 438 * MiB + 256 * 1024;
constexpr size_t WS_COEFQ = 388 * MiB;
constexpr size_t WS_SS2 = 439 * MiB;
constexpr size_t WS_H2Q = 388 * MiB;
constexpr size_t WS_PPART = 228 * MiB;
constexpr size_t WS_AMP = 440 * MiB;
constexpr size_t WS_R2 = 442 * MiB;
constexpr size_t WS_AMAX = 442 * MiB + 256 * 1024;
constexpr size_t WS_GMAX = 442 * MiB + 512 * 1024;
constexpr size_t WS_END = 443 * MiB;
constexpr int CW_RANK = 8192;
constexpr size_t KV_TENSOR = (size_t)NB * 2 * T * 64;

constexpr int LDS_BYTES = 147456;
constexpr int LDS_BARW = LDS_BYTES - 16;
constexpr int LDS_JOB = LDS_BYTES - 48;

__device__ __forceinline__ float bf2f(unsigned v) { return __uint_as_float(v << 16); }
__device__ __forceinline__ unsigned f2bf(float f) { unsigned u = __float_as_uint(f); return (u + 0x7fffu + ((u >> 16) & 1u)) >> 16; }
__device__ __forceinline__ unsigned pk2(float lo, float hi) { unsigned r; asm("v_cvt_pk_bf16_f32 %0, %1, %2" : "=v"(r) : "v"(lo), "v"(hi)); return r; }
__device__ __forceinline__ float wave_sum(float v) {
#pragma unroll
    for (int o = 1; o < 64; o <<= 1) v += __shfl_xor(v, o);
    return v;
}
__device__ __forceinline__ float gelu_erf(float v) { return 0.5f * v * (1.0f + erff(v * 0.70710678118654752f)); }

#define XB_TMO      128
#define XB_XCNT(j)  (256  + 64 * (j))
#define XB_XSUB(j)  (1280 + 64 * (j))
#define XB_XGEN(j)  (2304 + 64 * (j))
#define XB_TOP      3328
#define XB_TOPGEN   3392
#define XCD_BAR_WORDS 3456
#define XB_SPIN_CAP (1u << 18)

__device__ __forceinline__ unsigned xb_ld(unsigned* p)              { return __hip_atomic_load(p, __ATOMIC_RELAXED, __HIP_MEMORY_SCOPE_AGENT); }
__device__ __forceinline__ unsigned xb_add(unsigned* p, unsigned v) { return __hip_atomic_fetch_add(p, v, __ATOMIC_RELAXED, __HIP_MEMORY_SCOPE_AGENT); }
__device__ __forceinline__ unsigned xb_xcc_id() { return (unsigned)__builtin_amdgcn_s_getreg((3 << 11) | 20) & 0xFu; }
#define XB_SPIN(cond, bar) do { unsigned _sp = 0; while (cond) { __builtin_amdgcn_s_sleep(1); \
    if ((++_sp & 255u) == 0u) { if (xb_ld(&(bar)[XB_TMO])) break; if (_sp > XB_SPIN_CAP) { atomicAdd(&(bar)[XB_TMO], 1u); break; } } } } while (0)

struct XcdBarrier { unsigned* bar; unsigned x; volatile LAS unsigned* st; };

__device__ __forceinline__ XcdBarrier xcd_barrier_post(unsigned* bar, volatile LAS unsigned* st) {
    XcdBarrier b; b.bar = bar; b.x = xb_xcc_id(); b.st = st;
    if (threadIdx.x == 0) (void)xb_add(&bar[XB_XCNT(b.x)], 1u);
    return b;
}
__device__ __forceinline__ void xcd_barrier_complete(unsigned* bar, unsigned x, unsigned& nloc, unsigned& nx) {
    const unsigned G = gridDim.x * gridDim.y * gridDim.z;
    unsigned sum, cnt, mine, sp = 0u;
    for (;;) {
        sum = 0u; cnt = 0u; mine = 0u;
#pragma unroll
        for (unsigned j = 0; j < 16; ++j) { const unsigned c = xb_ld(&bar[XB_XCNT(j)]); sum += c; cnt += (c > 0u) ? 1u : 0u; mine = (j == x) ? c : mine; }
        if (sum == G) break;
        __builtin_amdgcn_s_sleep(1);
        if ((++sp & 255u) == 0u) { if (xb_ld(&bar[XB_TMO])) break; if (sp > XB_SPIN_CAP) { atomicAdd(&bar[XB_TMO], 1u); break; } }
    }
    nloc = mine > 0u ? mine : 1u; nx = cnt > 0u ? cnt : 1u;
}
__device__ __forceinline__ void xcd_barrier(const XcdBarrier& b) {
    asm volatile("s_waitcnt vmcnt(0)" ::: "memory");
    __syncthreads();
    if (threadIdx.x == 0) {
        unsigned* bar = b.bar;
        __builtin_amdgcn_s_waitcnt(0);
        unsigned nloc = b.st[0], nx = b.st[1];
        if (nloc == 0u) { xcd_barrier_complete(bar, b.x, nloc, nx); b.st[0] = nloc; b.st[1] = nx; }
        const unsigned old = xb_add(&bar[XB_XSUB(b.x)], 1u);
        const unsigned gen = old / nloc;
        if (old + 1u == (gen + 1u) * nloc) {
            __builtin_amdgcn_fence(__ATOMIC_RELEASE, "agent");
            asm volatile("s_waitcnt vmcnt(0)" ::: "memory");
            const unsigned og = xb_add(&bar[XB_TOP], 1u);
            const unsigned tg = og / nx;
            if (og + 1u == (tg + 1u) * nx) xb_add(&bar[XB_TOPGEN], 1u);
            else XB_SPIN(xb_ld(&bar[XB_TOPGEN]) == tg, bar);
            __builtin_amdgcn_fence(__ATOMIC_ACQUIRE, "agent");
            xb_add(&bar[XB_XGEN(b.x)], 1u);
            asm volatile("s_waitcnt vmcnt(0)" ::: "memory");
        } else {
            XB_SPIN(xb_ld(&bar[XB_XGEN(b.x)]) == gen, bar);
            __builtin_amdgcn_fence(__ATOMIC_ACQUIRE, "agent");
            asm volatile("s_waitcnt vmcnt(0)" ::: "memory");
        }
    }
    __syncthreads();
}

struct Args { const void* in[19]; float* out; unsigned char* ws; int ph_lo, ph_hi; };
enum { I_X = 0, I_POS, I_NORM_ATTN, I_W_IN, I_SINKS, I_CK_POS, I_CK_W1, I_CK_W2, I_CV_POS, I_CV_W1, I_CV_W2, I_W_OUT, I_NORM_FFN, I_W_QUERY, I_SK1, I_SK2, I_EDOWN, I_EUP, I_NORM_F };

constexpr int GT_LD = 72;
constexpr int GT_AS = 0, GT_BS = 128 * GT_LD * 2, GT_END = 2 * 128 * GT_LD * 2;
__device__ __forceinline__ void gemm_tile(const bf16* __restrict__ A, long lda, const bf16* __restrict__ Bt, long ldb, int K,
                                          LAS unsigned char* lds, f32x4 (&acc)[2][4], bool swap, int tid) {
    LAS bf16* As = (LAS bf16*)(lds + GT_AS);
    LAS bf16* Bs = (LAS bf16*)(lds + GT_BS);
    const int lane = tid & 63, w = tid >> 6, wr = w >> 1, wc = w & 1, fr = lane & 15, q = lane >> 4;
#pragma unroll
    for (int m = 0; m < 2; ++m)
#pragma unroll
        for (int n = 0; n < 4; ++n) acc[m][n] = (f32x4){0.f, 0.f, 0.f, 0.f};
    const int r0 = tid >> 3, kc = (tid & 7) * 8;
    for (int k0 = 0; k0 < K; k0 += 64) {
        u32x4 ra[2], rb[2];
#pragma unroll
        for (int i = 0; i < 2; ++i) {
            ra[i] = *(const u32x4*)(A + (long)(r0 + 64 * i) * lda + k0 + kc);
            rb[i] = *(const u32x4*)(Bt + (long)(r0 + 64 * i) * ldb + k0 + kc);
        }
        __syncthreads();
#pragma unroll
        for (int i = 0; i < 2; ++i) {
            *(LAS u32x4*)(As + (r0 + 64 * i) * GT_LD + kc) = ra[i];
            *(LAS u32x4*)(Bs + (r0 + 64 * i) * GT_LD + kc) = rb[i];
        }
        __syncthreads();
#pragma unroll
        for (int kk = 0; kk < 2; ++kk) {
            bf16x8 af[2], bfr[4];
#pragma unroll
            for (int m = 0; m < 2; ++m) af[m] = *(const LAS bf16x8*)(As + (32 * wr + 16 * m + fr) * GT_LD + 32 * kk + 8 * q);
#pragma unroll
            for (int n = 0; n < 4; ++n) bfr[n] = *(const LAS bf16x8*)(Bs + (64 * wc + 16 * n + fr) * GT_LD + 32 * kk + 8 * q);
            if (swap) {
#pragma unroll
                for (int m = 0; m < 2; ++m)
#pragma unroll
                    for (int n = 0; n < 4; ++n) acc[m][n] = __builtin_amdgcn_mfma_f32_16x16x32_bf16(bfr[n], af[m], acc[m][n], 0, 0, 0);
            } else {
#pragma unroll
                for (int m = 0; m < 2; ++m)
#pragma unroll
                    for (int n = 0; n < 4; ++n) acc[m][n] = __builtin_amdgcn_mfma_f32_16x16x32_bf16(af[m], bfr[n], acc[m][n], 0, 0, 0);
            }
        }
    }
    __syncthreads();
}

namespace pg8 {
#define PG8_LAS __attribute__((address_space(3)))
typedef unsigned short bf16_t;
typedef short bf16x8 __attribute__((ext_vector_type(8)));
typedef float f32x4 __attribute__((ext_vector_type(4)));
typedef unsigned u32x4 __attribute__((ext_vector_type(4)));
constexpr int BM = 256, BK = 64, HALF = 128, HTB = HALF * BK * 2  , STAGE_BYTES = 8 * HTB, NXCD = 8, WGM = 8;

__host__ __device__ __forceinline__ int lds_byte(int r, int c) { const int st = (r >> 4) * 2 + (c >> 5), rr = r & 15, cc = c & 31, ob = rr * 64 + cc * 2; return st * 1024 + (ob ^ (((ob >> 9) & 1) << 5)); }
__host__ __device__ __forceinline__ void stage_rc(int b, int& R, int& C) { const int st = b / 1024, sb = b % 1024, swz = sb ^ (((sb >> 9) & 1) << 5); R = (st >> 1) * 16 + swz / 64; C = (st & 1) * 32 + (swz % 64) / 2; }
__host__ __device__ __forceinline__ int perm32(int rho) { const int n = rho >> 4, i = rho & 15; return 8 * (i >> 2) + 4 * n + (i & 3); }

struct Unit { int pm, pn; };
struct Gemm { const bf16_t* A; const bf16_t* Bt; int M, N, K; };

struct StaticOrder {
    int nM, nN, nwg, G, c;
    __host__ __device__ void init(int M, int N, int G_, int c_) { nM = M / BM; nN = N / BM; nwg = nM * nN; G = G_; c = c_; }
    __host__ __device__ bool next(int i, Unit& u) const {
        const long L = (long)i * G + c; if (L >= nwg) return false;
        int wgid = (int)L; { const int q = nwg / NXCD, r = nwg % NXCD, xcd = wgid % NXCD, off = wgid / NXCD; wgid = (xcd < r ? xcd * (q + 1) : r * (q + 1) + (xcd - r) * q) + off; }
        const int nig = WGM * nN, gid = wgid / nig, fm = gid * WGM, gsz = (nM - fm) < WGM ? (nM - fm) : WGM;
        u.pm = fm + ((wgid % nig) % gsz); u.pn = (wgid % nig) / gsz; return true;
    }
    __device__ __forceinline__ void a_ready(const Unit&) const {}
    __device__ __forceinline__ void done(const Unit&) const {}
};

__device__ __forceinline__ unsigned cvt_pk_bf16(float lo, float hi) { unsigned r; asm volatile("v_cvt_pk_bf16_f32 %0, %1, %2" : "=v"(r) : "v"(lo), "v"(hi)); return r; }
typedef float f32x2 __attribute__((ext_vector_type(2)));
__device__ __forceinline__ f32x2 gelu_pk(f32x2 v) {
    const f32x2 av = __builtin_elementwise_abs(v), d = av * 0.2316418882f + 1.0f;
    f32x2 t; t.x = __builtin_amdgcn_rcpf(d.x); t.y = __builtin_amdgcn_rcpf(d.y);
    f32x2 q = t * 0.5307027145f + (-0.7265760135f); q = q * t + 0.7107068705f; q = q * t + (-0.142248368f); q = q * t + 0.127414796f; q = q * t;
    const f32x2 s = (v * v) * (-0.72134752044f);
    f32x2 e; e.x = __builtin_amdgcn_exp2f(s.x); e.y = __builtin_amdgcn_exp2f(s.y);
    const f32x2 m = v * (q * e), r = v - m;
    f32x2 o; o.x = v.x < 0.f ? m.x : r.x; o.y = v.y < 0.f ? m.y : r.y; return o;
}

template <int ACT  > struct EpiBf16 {
    static constexpr bool PERM = true, AFTER_DRAIN = false; static_assert(ACT == 0 || ACT == 1, "EpiBf16: ACT is 0 (none) or 1 (gelu_pk)");
    bf16_t* O; int ldc; const float* bias; int split_cols; size_t split_stride; float scale0;
    __device__ __forceinline__ void operator()(const f32x4 (&acc)[2][2][4][2], const Unit& u, int wr, int wc, int fr, int fq) const {
        const int row0 = u.pm * BM + wr * 64 + fr; int colt = u.pn * BM; bf16_t* base = O;
        float sc = 1.f; if (split_cols) { const int t = colt / split_cols; base += (size_t)t * split_stride; colt -= t * split_cols; if (t == 0) sc = scale0; }
        const int col0 = colt + wc * 32 + 8 * fq, bcol0 = u.pn * BM + wc * 32 + 8 * fq;
        f32x4 bv[2][2];
#pragma unroll
        for (int bj = 0; bj < 2; ++bj)
#pragma unroll
            for (int n = 0; n < 2; ++n) bv[bj][n] = bias ? *(const f32x4*)(bias + bcol0 + bj * HALF + 4 * n) : (f32x4){0.f, 0.f, 0.f, 0.f};
#pragma unroll
        for (int ai = 0; ai < 2; ++ai)
#pragma unroll
            for (int m = 0; m < 4; ++m) { bf16_t* rowp = base + (size_t)(row0 + ai * HALF + m * 16) * ldc + col0;
#pragma unroll
                for (int bj = 0; bj < 2; ++bj) { f32x4 v0 = acc[ai][bj][m][0] + bv[bj][0], v1 = acc[ai][bj][m][1] + bv[bj][1];
                    if (ACT == 1) { f32x2 a = gelu_pk((f32x2){v0[0], v0[1]}), b = gelu_pk((f32x2){v0[2], v0[3]}), c = gelu_pk((f32x2){v1[0], v1[1]}), d = gelu_pk((f32x2){v1[2], v1[3]});
                        v0 = (f32x4){a.x, a.y, b.x, b.y}; v1 = (f32x4){c.x, c.y, d.x, d.y}; }
                    v0 = v0 * sc; v1 = v1 * sc; u32x4 w; w.x = cvt_pk_bf16(v0[0], v0[1]); w.y = cvt_pk_bf16(v0[2], v0[3]); w.z = cvt_pk_bf16(v1[0], v1[1]); w.w = cvt_pk_bf16(v1[2], v1[3]);
                    *(u32x4*)(rowp + bj * HALF) = w; } }
    }
};
template <class Epi, class Sched, bool ALIGN_EPI = false, bool SP2 = false>
__device__ __forceinline__ void gemm_phase(PG8_LAS unsigned char* lds, const Gemm g, const Sched& S, const Epi& E) {
    int tid_ = threadIdx.x; asm volatile("" : "+v"(tid_));
    const int tid = tid_, wid = __builtin_amdgcn_readfirstlane(tid >> 6), lane = tid & 63, wr = wid >> 2, wc = wid & 3, fr = lane & 15, fq = lane >> 4;
    const int K = g.K, nt = K / BK;
    unsigned voffA[2], voffB[2];
#pragma unroll
    for (int i = 0; i < 2; ++i) { int R, C; stage_rc(tid * 16 + i * 8192, R, C); const int Rb = Epi::PERM ? ((R & ~31) + perm32(R & 31)) : R;
        voffA[i] = (unsigned)(R * K + C) * 2u; voffB[i] = (unsigned)(Rb * K + C) * 2u; }
    const size_t kstep = (size_t)(BK * 2);
    const size_t hstep = (size_t)HALF * K * 2;
    const size_t tstep = 2 * hstep;
    const unsigned ldsw = (unsigned)wid * 1024u;
    const int aoff = lds_byte(wr * 64 + fr, fq * 8), boff = lds_byte(wc * 32 + fr, fq * 8);
#define PG8_SA(b, h) (((b) * 2 + (h)) * HTB)
#define PG8_SB(b, h) ((4 + (b) * 2 + (h)) * HTB)
#define PG8_STAGE(bufoff, gbase, voff) do { _Pragma("unroll") for (int _i = 0; _i < 2; ++_i) \
        __builtin_amdgcn_global_load_lds((const unsigned*)((const char*)(gbase) + (voff)[_i]), (PG8_LAS unsigned*)(lds + (bufoff) + ldsw + _i * 8192), 16, 0, 0); } while (0)
#define PG8_LDA(dst, b, h) do { _Pragma("unroll") for (int m = 0; m < 4; ++m) _Pragma("unroll") for (int k = 0; k < 2; ++k) dst[m][k] = *(const PG8_LAS bf16x8*)(lds + PG8_SA(b, h) + aoff + m * 2048 + k * 1024); } while (0)
#define PG8_LDB(dst, b, h) do { _Pragma("unroll") for (int n = 0; n < 2; ++n) _Pragma("unroll") for (int k = 0; k < 2; ++k) dst[n][k] = *(const PG8_LAS bf16x8*)(lds + PG8_SB(b, h) + boff + n * 2048 + k * 1024); } while (0)
#define PG8_MMA(ai, bj, At, Bt) do { __builtin_amdgcn_s_setprio(1); _Pragma("unroll") for (int m = 0; m < 4; ++m) _Pragma("unroll") for (int n = 0; n < 2; ++n) _Pragma("unroll") for (int k = 0; k < 2; ++k) \
        acc[ai][bj][m][n] = __builtin_amdgcn_mfma_f32_16x16x32_bf16(Bt[n][k], At[m][k], acc[ai][bj][m][n], 0, 0, 0); __builtin_amdgcn_s_setprio(0); } while (0)
#define PG8_WAIT_V(n) asm volatile("s_waitcnt vmcnt(" #n ")" ::: "memory")
#define PG8_WAIT_L(n) asm volatile("s_waitcnt lgkmcnt(" #n ")" ::: "memory")
#define PG8_BAR __builtin_amdgcn_s_barrier()
#define PG8_SCHED __builtin_amdgcn_sched_barrier(0)
    Unit cur, nxt; int ui = 0;
    if (!S.next(0, cur)) return;
    f32x4 acc[2][2][4][2];
#pragma unroll
    for (int a = 0; a < 2; ++a)
#pragma unroll
        for (int b = 0; b < 2; ++b)
#pragma unroll
            for (int m = 0; m < 4; ++m)
#pragma unroll
                for (int n = 0; n < 2; ++n) acc[a][b][m][n] = (f32x4){0.f, 0.f, 0.f, 0.f};
    bf16x8 At[4][2], B0[2][2], B1[2][2];
    const char* cA = (const char*)g.A + (size_t)cur.pm * tstep; const char* cB = (const char*)g.Bt + (size_t)cur.pn * tstep;
    S.a_ready(cur);
    if constexpr (SP2) {
        PG8_STAGE(PG8_SB(0, 0), cB, voffB); PG8_STAGE(PG8_SB(0, 1), cB + hstep, voffB); PG8_STAGE(PG8_SA(0, 0), cA, voffA); PG8_STAGE(PG8_SA(0, 1), cA + hstep, voffA);
        if (wr == 1) PG8_BAR;
        PG8_WAIT_V(2); PG8_BAR;
        PG8_STAGE(PG8_SB(1, 0), cB + kstep, voffB); PG8_STAGE(PG8_SA(1, 0), cA + kstep, voffA); PG8_STAGE(PG8_SB(1, 1), cB + hstep + kstep, voffB);
        PG8_WAIT_V(6); PG8_BAR;
    } else {
        PG8_STAGE(PG8_SB(0, 0), cB, voffB); PG8_STAGE(PG8_SA(0, 0), cA, voffA); PG8_STAGE(PG8_SB(0, 1), cB + hstep, voffB); PG8_STAGE(PG8_SA(0, 1), cA + hstep, voffA);
        if (wr == 1) PG8_BAR;
        PG8_WAIT_V(4); PG8_BAR;
        PG8_STAGE(PG8_SB(1, 0), cB + kstep, voffB); PG8_STAGE(PG8_SA(1, 0), cA + kstep, voffA); PG8_STAGE(PG8_SB(1, 1), cB + hstep + kstep, voffB);
        PG8_WAIT_V(6); PG8_BAR;
    }
    for (;;) {
        const bool has_next = S.next(ui + 1, nxt);
        const char* nA = has_next ? (const char*)g.A + (size_t)nxt.pm * tstep : cA; const char* nB = has_next ? (const char*)g.Bt + (size_t)nxt.pn * tstep : cB;
        for (int t = 0; t < nt; t += 2) {
            const bool last = (t == nt - 2);
            const char* a1 = cA + (size_t)(t + 1) * kstep;
            const char* a2 = last ? nA : cA + (size_t)(t + 2) * kstep; const char* b2 = last ? nB : cB + (size_t)(t + 2) * kstep;
            const char* a3 = a2 + kstep; const char* b3 = b2 + kstep;
            if (last && has_next) S.a_ready(nxt);
            if constexpr (SP2) {
            PG8_LDB(B0, 0, 0); PG8_LDB(B1, 0, 1); PG8_SCHED; PG8_LDA(At, 0, 0); PG8_STAGE(PG8_SA(1, 1), a1 + hstep, voffA);
            PG8_WAIT_V(8); PG8_WAIT_L(0); PG8_BAR; PG8_MMA(0, 0, At, B0); PG8_MMA(0, 1, At, B1); PG8_BAR; PG8_SCHED;
            PG8_LDA(At, 0, 1); PG8_STAGE(PG8_SB(0, 0), b2, voffB); PG8_STAGE(PG8_SB(0, 1), b2 + hstep, voffB); PG8_STAGE(PG8_SA(0, 0), a2, voffA);
            PG8_WAIT_V(8); PG8_WAIT_L(0); PG8_BAR; PG8_MMA(1, 0, At, B0); PG8_MMA(1, 1, At, B1); PG8_BAR; PG8_SCHED;
            PG8_LDB(B0, 1, 0); PG8_LDB(B1, 1, 1); PG8_SCHED; PG8_LDA(At, 1, 0); PG8_STAGE(PG8_SA(0, 1), a2 + hstep, voffA);
            PG8_WAIT_V(8); PG8_WAIT_L(0); PG8_BAR; PG8_MMA(0, 0, At, B0); PG8_MMA(0, 1, At, B1); PG8_BAR; PG8_SCHED;
            PG8_LDA(At, 1, 1); PG8_STAGE(PG8_SB(1, 0), b3, voffB); PG8_STAGE(PG8_SB(1, 1), b3 + hstep, voffB); PG8_STAGE(PG8_SA(1, 0), a3, voffA);
            PG8_WAIT_V(8); PG8_WAIT_L(0); PG8_BAR; PG8_MMA(1, 0, At, B0); PG8_MMA(1, 1, At, B1); PG8_BAR; PG8_SCHED;
            } else {
            PG8_LDB(B0, 0, 0); PG8_SCHED; PG8_LDA(At, 0, 0); PG8_STAGE(PG8_SA(1, 1), a1 + hstep, voffA);
            PG8_WAIT_L(8); PG8_BAR; PG8_WAIT_L(0); PG8_MMA(0, 0, At, B0); PG8_BAR; PG8_SCHED;
            PG8_LDB(B1, 0, 1); PG8_STAGE(PG8_SB(0, 0), b2, voffB);
            PG8_BAR; PG8_WAIT_L(0); PG8_MMA(0, 1, At, B1); PG8_BAR;
            PG8_LDA(At, 0, 1); PG8_STAGE(PG8_SA(0, 0), a2, voffA);
            PG8_BAR; PG8_WAIT_L(0); PG8_MMA(1, 0, At, B0); PG8_BAR; PG8_SCHED;
            PG8_STAGE(PG8_SB(0, 1), b2 + hstep, voffB);
            PG8_WAIT_V(6); PG8_BAR; PG8_MMA(1, 1, At, B1); PG8_BAR;
            PG8_LDB(B0, 1, 0); PG8_SCHED; PG8_LDA(At, 1, 0); PG8_STAGE(PG8_SA(0, 1), a2 + hstep, voffA);
            PG8_WAIT_L(8); PG8_BAR; PG8_WAIT_L(0); PG8_MMA(0, 0, At, B0); PG8_BAR; PG8_SCHED;
            PG8_LDB(B1, 1, 1); PG8_STAGE(PG8_SB(1, 0), b3, voffB);
            PG8_BAR; PG8_WAIT_L(0); PG8_MMA(0, 1, At, B1); PG8_BAR;
            PG8_LDA(At, 1, 1); PG8_STAGE(PG8_SA(1, 0), a3, voffA);
            PG8_BAR; PG8_WAIT_L(0); PG8_MMA(1, 0, At, B0); PG8_BAR; PG8_SCHED;
            PG8_STAGE(PG8_SB(1, 1), b3 + hstep, voffB);
            PG8_WAIT_V(6); PG8_BAR; PG8_MMA(1, 1, At, B1); PG8_BAR;
            }
        }
        if constexpr (ALIGN_EPI) { if (wr == 0) PG8_BAR; }
        if constexpr (!Epi::AFTER_DRAIN) { E(acc, cur, wr, wc, fr, fq); S.done(cur); }
        if (!has_next) break;
#pragma unroll
        for (int a = 0; a < 2; ++a)
#pragma unroll
            for (int b = 0; b < 2; ++b)
#pragma unroll
                for (int m = 0; m < 4; ++m)
#pragma unroll
                    for (int n = 0; n < 2; ++n) acc[a][b][m][n] = (f32x4){0.f, 0.f, 0.f, 0.f};
        cur = nxt; cA = nA; cB = nB; ++ui;
        if constexpr (ALIGN_EPI) { if (wr == 1) PG8_BAR; }
    }
    PG8_WAIT_V(0);
    if constexpr (!ALIGN_EPI) { if (wr == 0) PG8_BAR; }
    PG8_BAR;
    if constexpr (Epi::AFTER_DRAIN) { E.fused(acc, cur, wr, wc, fr, fq, lds, wid, lane); S.done(cur); }
#undef PG8_SA
#undef PG8_SB
#undef PG8_STAGE
#undef PG8_LDA
#undef PG8_LDB
#undef PG8_MMA
#undef PG8_WAIT_V
#undef PG8_WAIT_L
#undef PG8_BAR
#undef PG8_SCHED
}
}

__host__ __device__ __forceinline__ int inproj_col(int n) { const int p = n & 63, g = p >> 3, j = p & 7; return (n & ~63) + ((j < 4) ? 4 * g + j : 32 + 4 * g + (j - 4)); }
__device__ __forceinline__ void transpose_w(const float* __restrict__ W, int K, int Nsrc, int col_off, int nvalid, int Npad, bool perm, bf16* __restrict__ WT, long gtid, long ngt, const float* __restrict__ kgain = nullptr) {
    const long items = (long)Npad * (K / 8);
    for (long it = gtid; it < items; it += ngt) {
        const int n = (int)(it % Npad), kc = (int)(it / Npad) * 8;
        const int sc = col_off + (perm ? inproj_col(n) : n);
        float v[8];
#pragma unroll
        for (int j = 0; j < 8; ++j) v[j] = (n < nvalid) ? W[(long)(kc + j) * Nsrc + sc] * (kgain ? kgain[kc + j] : 1.0f) : 0.f;
        u32x4 o; o.x = pk2(v[0], v[1]); o.y = pk2(v[2], v[3]); o.z = pk2(v[4], v[5]); o.w = pk2(v[6], v[7]);
        *(u32x4*)(WT + (long)n * K + kc) = o;
    }
}
__device__ __forceinline__ void convert_bf16(const float* __restrict__ src, bf16* __restrict__ dst, long n, long gtid, long ngt) {
    for (long i = gtid * 8; i < n; i += ngt * 8) {
        const f32x4 a = *(const f32x4*)(src + i), b = *(const f32x4*)(src + i + 4);
        u32x4 o; o.x = pk2(a[0], a[1]); o.y = pk2(a[2], a[3]); o.z = pk2(b[0], b[1]); o.w = pk2(b[2], b[3]);
        *(u32x4*)(dst + i) = o;
    }
}
__device__ __forceinline__ void rms_row_bf16(const float* __restrict__ xrow, const float* __restrict__ g, bf16* __restrict__ orow, int lane) {
    f32x4 v[4]; float ss = 0.f;
#pragma unroll
    for (int j = 0; j < 4; ++j) { v[j] = *(const f32x4*)(xrow + (lane + 64 * j) * 4); ss += (v[j][0] * v[j][0] + v[j][1] * v[j][1]) + (v[j][2] * v[j][2] + v[j][3] * v[j][3]); }
    const float r = rsqrtf(wave_sum(ss) * (1.0f / D) + RMS_EPS);
#pragma unroll
    for (int j = 0; j < 4; ++j) {
        const f32x4 gg = *(const f32x4*)(g + (lane + 64 * j) * 4);
        u32x2 o; o.x = pk2(v[j][0] * r * gg[0], v[j][1] * r * gg[1]); o.y = pk2(v[j][2] * r * gg[2], v[j][3] * r * gg[3]);
        *(u32x2*)(orow + (lane + 64 * j) * 4) = o;
    }
}

__device__ __forceinline__ void quant_experts(const Args& a, int lane, int gw, int ngw, int r_lo, int r_hi) {
    unsigned char* ws = a.ws;
    for (int r = r_lo + gw; r < r_hi; r += ngw) {
        const int up = r >= 16384, e = r & 16383;
        const float* src = (const float*)a.in[up ? I_EUP : I_EDOWN] + (size_t)e * D;
        f32x4 v[4]; float am = 0.f, ssq = 0.f;
#pragma unroll
        for (int j = 0; j < 4; ++j) { v[j] = *(const f32x4*)(src + (lane + 64 * j) * 4); am = fmaxf(am, fmaxf(fmaxf(fabsf(v[j][0]), fabsf(v[j][1])), fmaxf(fabsf(v[j][2]), fabsf(v[j][3]))));
            ssq += (v[j][0] * v[j][0] + v[j][1] * v[j][1]) + (v[j][2] * v[j][2] + v[j][3] * v[j][3]); }
#pragma unroll
        for (int o = 1; o < 64; o <<= 1) { am = fmaxf(am, __shfl_xor(am, o)); ssq += __shfl_xor(ssq, o); }
        am = fmaxf(am, 1e-30f);
        {
            const float cl = fmaxf(fminf(am, 2.6f * sqrtf(ssq * (1.0f / D))), 1e-30f), inv = 7.0f / cl;
            unsigned char* dst = ws + (up ? WS_EUP : WS_EDOWN) + (size_t)e * 128;
#pragma unroll
            for (int j = 0; j < 4; ++j) {
                unsigned w = 0;
#pragma unroll
                for (int c = 0; c < 4; ++c) w |= ((unsigned)((int)fminf(fmaxf(rintf(v[j][c] * inv), -7.f), 7.f) + ((up && !(c & 1)) ? 8 : 0)) & 0xfu) << (4 * c);
                const int d = (lane + 64 * j) * 4;
                *(unsigned short*)(dst + (size_t)(d >> 8) * 16384 * 128 + ((d & 255) >> 1)) = (unsigned short)w;
            }
            if (lane == 0) ((float*)(ws + (up ? WS_ESU : WS_ESD)))[e] = cl * (1.0f / 7.0f);
        }
    }
}

__device__ __forceinline__ void phase0(const Args& a, int tid) {
    unsigned char* ws = a.ws;
    const long gtid = (long)blockIdx.x * 512 + tid, ngt = (long)gridDim.x * 512;
    const int lane = tid & 63, gw = blockIdx.x * 8 + (tid >> 6), ngw = gridDim.x * 8;
    transpose_w((const float*)a.in[I_W_IN], D, INW, 0, 2048, 2048, true, (bf16*)(ws + WS_WIN_T), gtid, ngt);
    transpose_w((const float*)a.in[I_W_IN], D, INW, 2048, 24, 128, false, (bf16*)(ws + WS_WG_T), gtid, ngt);
    transpose_w((const float*)a.in[I_W_OUT], D, D, 0, D, D, false, (bf16*)(ws + WS_WOUT_T), gtid, ngt);
    transpose_w((const float*)a.in[I_W_QUERY], D, 2048, 0, 2048, 2048, false, (bf16*)(ws + WS_WQ_T), gtid, ngt, (const float*)a.in[I_NORM_FFN]);
    transpose_w((const float*)a.in[I_CK_W1], 2048, 256, 0, 256, 256, false, (bf16*)(ws + WS_CW1_T), gtid, ngt);
    transpose_w((const float*)a.in[I_CV_W1], 2048, 256, 0, 256, 256, false, (bf16*)(ws + WS_CW1_T) + 256 * 2048, gtid, ngt);
    transpose_w((const float*)a.in[I_CK_W2], 256, 64, 0, 64, 128, false, (bf16*)(ws + WS_CW2_T), gtid, ngt);
    transpose_w((const float*)a.in[I_CV_W2], 256, 64, 0, 64, 128, false, (bf16*)(ws + WS_CW2_T) + 128 * 256, gtid, ngt);
    convert_bf16((const float*)a.in[I_SK1], (bf16*)(ws + WS_SUBK), 128 * 128, gtid, ngt);
    convert_bf16((const float*)a.in[I_SK2], (bf16*)(ws + WS_SUBK) + 128 * 128, 128 * 128, gtid, ngt);
    if (gw == 0) {
        const float* nf = (const float*)a.in[I_NORM_FFN]; float m = 0.f;
        for (int k = lane; k < D; k += 64) m = fmaxf(m, fabsf(nf[k]));
#pragma unroll
        for (int o = 1; o < 64; o <<= 1) m = fmaxf(m, __shfl_xor(m, o));
        if (lane == 0) *(float*)(ws + WS_GMAX) = fmaxf(m, 1e-30f);
    }
    for (int o = gw; o < 512; o += ngw) {
        const int ten = o >> 8, n = o & 255;
        const float* pos = (const float*)a.in[ten ? I_CV_POS : I_CK_POS];
        const float* w1 = (const float*)a.in[ten ? I_CV_W1 : I_CK_W1];
        float s = 0.f;
        for (int k = lane; k < 2048; k += 64) s += pos[k] * w1[(long)k * 256 + n];
        s = wave_sum(s);
        if (lane == 0) ((float*)(ws + WS_CB1))[o] = s;
    }
    {
        const int* pos = (const int*)a.in[I_POS];
        float* rc = (float*)(ws + WS_ROPE_C); float* rs = (float*)(ws + WS_ROPE_S);
        for (long it = gtid; it < (long)NTOK * 32; it += ngt) {
            const int tok = (int)(it >> 5), f = (int)(it & 31);
            const float inv = powf(10000.0f, -(float)f / 32.0f);
            const float ang = (float)pos[tok] * inv;
            float sv, cv; sincosf(ang, &sv, &cv);
            rc[it] = cv; rs[it] = sv;
        }
    }
    if (gw < NTOK) {
        const float* X = (const float*)a.in[I_X]; const float* gn = (const float*)a.in[I_NORM_ATTN];
        f32x4 v[4], nx[4], gg4[4];
#pragma unroll
        for (int j = 0; j < 4; ++j) { v[j] = *(const f32x4*)(X + (long)gw * D + (lane + 64 * j) * 4); gg4[j] = *(const f32x4*)(gn + (lane + 64 * j) * 4); }
        for (int r = gw; r < NTOK; r += ngw) {
            const float* nrow = X + (long)min(r + ngw, NTOK - 1) * D;
#pragma unroll
            for (int j = 0; j < 4; ++j) nx[j] = *(const f32x4*)(nrow + (lane + 64 * j) * 4);
            float ss = 0.f;
#pragma unroll
            for (int j = 0; j < 4; ++j) ss += (v[j][0] * v[j][0] + v[j][1] * v[j][1]) + (v[j][2] * v[j][2] + v[j][3] * v[j][3]);
            const float rr = rsqrtf(wave_sum(ss) * (1.0f / D) + RMS_EPS);
            bf16* orow = (bf16*)(ws + WS_H) + (long)r * D;
#pragma unroll
            for (int j = 0; j < 4; ++j) {
                const f32x4 gg = gg4[j];
                u32x2 o; o.x = pk2(v[j][0] * rr * gg[0], v[j][1] * rr * gg[1]); o.y = pk2(v[j][2] * rr * gg[2], v[j][3] * rr * gg[3]);
                *(u32x2*)(orow + (lane + 64 * j) * 4) = o;
            }
#pragma unroll
            for (int j = 0; j < 4; ++j) v[j] = nx[j];
        }
    }
}

constexpr float QSCALE = 0.125f * 1.4426950408889634f;
struct EpiInProj {
    static constexpr bool PERM = true, AFTER_DRAIN = false;
    bf16* QKV;
    const float* RC;
    __device__ __forceinline__ void operator()(const f32x4 (&acc)[2][2][4][2], const pg8::Unit& u, int wr, int wc, int fr, int fq) const {
        const int b = (u.pm * 256) / T, tb = (u.pm * 256) % T, d0 = 16 * (wc & 1) + 4 * fq;
        bool rope2[2]; float sc2[2]; bf16* base2[2];
#pragma unroll
        for (int bj = 0; bj < 2; ++bj) {
            const int cb = 4 * u.pn + 2 * bj + (wc >> 1);
            const bool isq = (cb < 8) || (cb >= 12 && cb < 20);
            const int hq = cb < 8 ? cb : cb - 4, ti = cb < 12 ? ((cb - 8) >> 1) : 2 + ((cb - 20) >> 1);
            rope2[bj] = isq || ((ti & 1) == 0);
            sc2[bj] = isq ? QSCALE : 1.0f;
            const unsigned eoff = isq ? (unsigned)((b * 16 + hq) * T) * 64u : (unsigned)(NB * 16 * T * 64) + (unsigned)ti * (unsigned)KV_TENSOR + (unsigned)((b * 2 + (cb & 1)) * T) * 64u;
            base2[bj] = QKV + eoff;
        }
#pragma unroll
        for (int ai = 0; ai < 2; ++ai)
#pragma unroll
            for (int m = 0; m < 4; ++m) {
                const int t = tb + 128 * ai + 64 * wr + 16 * m + fr;
                const float* rp = RC + ((size_t)b * T + t) * 32 + d0;
                const f32x4 c4 = *(const f32x4*)rp, s4 = *(const f32x4*)(rp + (size_t)NTOK * 32);
#pragma unroll
                for (int bj = 0; bj < 2; ++bj) {
                    f32x4 o1 = acc[ai][bj][m][0], o2 = acc[ai][bj][m][1];
                    if (rope2[bj]) {
                        const f32x4 x1 = o1, x2 = o2;
                        o1 = (x1 * c4 - x2 * s4) * sc2[bj]; o2 = (x2 * c4 + x1 * s4) * sc2[bj];
                    }
                    u32x2 w1; w1.x = pk2(o1[0], o1[1]); w1.y = pk2(o1[2], o1[3]);
                    u32x2 w2; w2.x = pk2(o2[0], o2[1]); w2.y = pk2(o2[2], o2[3]);
                    *(u32x2*)(base2[bj] + (size_t)t * 64 + d0) = w1;
                    *(u32x2*)(base2[bj] + (size_t)t * 64 + 32 + d0) = w2;
                }
            }
    }
};
__device__ __forceinline__ void phase1(const Args& a, LAS unsigned char* lds, int tid) {
    unsigned char* ws = a.ws;
    {
        pg8::Gemm g{(const bf16*)(ws + WS_H), (const bf16*)(ws + WS_WIN_T), NTOK, 2048, D};
        pg8::StaticOrder S; S.init(NTOK, 2048, (int)gridDim.x, (int)blockIdx.x);
        EpiInProj E{(bf16*)(ws + WS_Q), (const float*)(ws + WS_ROPE_C)};
        static_assert(WS_KV == WS_Q + (size_t)NB * 16 * T * 64 * 2 && WS_ROPE_S == WS_ROPE_C + (size_t)NTOK * 32 * 4, "EpiInProj layout assumptions");
        pg8::gemm_phase<EpiInProj, pg8::StaticOrder, true, true>(lds, g, S, E);
    }
}

__device__ __forceinline__ void gates_gemm(const Args& a, LAS unsigned char* lds, int tid, int first, int step) {
    unsigned char* ws = a.ws;
    const bf16* H = (const bf16*)(ws + WS_H); const bf16* WG = (const bf16*)(ws + WS_WG_T); float* G = (float*)(ws + WS_GATES);
    const int lane = tid & 63, w = tid >> 6, wr = w >> 1, wc = w & 1, fr = lane & 15, q = lane >> 4;
    for (int pm = first; pm < NTOK / 128; pm += step) {
        f32x4 acc[2][4];
        gemm_tile(H + (long)pm * 128 * D, D, WG, D, D, lds, acc, true, tid);
        if (wc == 0) {
#pragma unroll
            for (int m = 0; m < 2; ++m) {
                const long tok = (long)pm * 128 + 32 * wr + 16 * m + fr;
#pragma unroll
                for (int n = 0; n < 2; ++n)
#pragma unroll
                    for (int r = 0; r < 4; ++r) { const int col = 16 * n + 4 * q + r; if (col < 24) G[tok * 24 + col] = 1.0f / (1.0f + __expf(-acc[m][n][r])); }
            }
        }
    }
}

constexpr int P2_EXPERT_ROWS = 4096;
__device__ __forceinline__ void phase2(const Args& a, LAS unsigned char* lds, int tid) {
    unsigned char* ws = a.ws;
    const bf16* KR = (const bf16*)(ws + WS_KV); const bf16* W1 = (const bf16*)(ws + WS_CW1_T); const float* B1 = (const float*)(ws + WS_CB1);
    bf16* HID = (bf16*)(ws + WS_CHID);
    const int lane = tid & 63, w = tid >> 6, wr = w >> 1, wc = w & 1, fr = lane & 15, q = lane >> 4;
    const bool split = gridDim.x >= 256;
    const int nmain = split ? 128 : (int)gridDim.x, nside = split ? (int)gridDim.x - 128 : (int)gridDim.x, si = split ? (int)blockIdx.x - 128 : (int)blockIdx.x;
    if (!split || blockIdx.x >= 128) {
        gates_gemm(a, lds, tid, si, nside);
        quant_experts(a, lane, si * 8 + w, nside * 8, 0, P2_EXPERT_ROWS);
    }
    if (split && blockIdx.x >= 128) return;
    for (int u = blockIdx.x; u < 32 * 4; u += nmain) {
        const int z = u >> 2, pm = (u >> 1) & 1, pn = u & 1, ten = z >> 4, bh = z & 15;
        const bf16* A = KR + (size_t)(ten ? 3 : 2) * KV_TENSOR + (size_t)bh * T * 64 + (size_t)pm * 128 * 1024;
        f32x4 acc[2][4];
        gemm_tile(A, 1024, W1 + (size_t)ten * 256 * 2048 + (size_t)pn * 128 * 2048, 2048, 2048, lds, acc, true, tid);
#pragma unroll
        for (int m = 0; m < 2; ++m) {
            const int row = pm * 128 + 32 * wr + 16 * m + fr;
#pragma unroll
            for (int n = 0; n < 4; ++n) {
                const int col = pn * 128 + 64 * wc + 16 * n + 4 * q;
                const f32x4 bb = *(const f32x4*)(B1 + ten * 256 + col);
                f32x4 v = acc[m][n] + bb;
                u32x2 o; o.x = pk2(gelu_erf(v[0]), gelu_erf(v[1])); o.y = pk2(gelu_erf(v[2]), gelu_erf(v[3]));
                *(u32x2*)(HID + ((size_t)z * 256 + row) * 256 + col) = o;
            }
        }
    }
}
__device__ __forceinline__ void phase3(const Args& a, LAS unsigned char* lds, int tid) {
    unsigned char* ws = a.ws;
    const bf16* HID = (const bf16*)(ws + WS_CHID); const bf16* W2 = (const bf16*)(ws + WS_CW2_T);
    bf16* KC = (bf16*)(ws + WS_KCMP); bf16* VC = (bf16*)(ws + WS_VCMP);
    const int lane = tid & 63, w = tid >> 6, wr = w >> 1, wc = w & 1, fr = lane & 15, q = lane >> 4;
    const bool split = gridDim.x >= 128;
    const int nmain = split ? 64 : (int)gridDim.x, nside = split ? (int)gridDim.x - 64 : (int)gridDim.x, si = split ? (int)blockIdx.x - 64 : (int)blockIdx.x;
    if (!split || blockIdx.x >= 64) quant_experts(a, lane, si * 8 + w, nside * 8, P2_EXPERT_ROWS, 2 * 16384);
    if (split && blockIdx.x >= 64) return;
    for (int u = blockIdx.x; u < 32 * 2; u += nmain) {
        const int z = u >> 1, pm = u & 1, ten = z >> 4, bh = z & 15;
        f32x4 acc[2][4];
        gemm_tile(HID + ((size_t)z * 256 + pm * 128) * 256, 256, W2 + (size_t)ten * 128 * 256, 256, 256, lds, acc, true, tid);
        if (wc == 0) {
            bf16* dst = ten ? VC : KC;
#pragma unroll
            for (int m = 0; m < 2; ++m) {
                const int c = pm * 128 + 32 * wr + 16 * m + fr;
#pragma unroll
                for (int n = 0; n < 4; ++n) {
                    u32x2 o; o.x = pk2(acc[m][n][0], acc[m][n][1]); o.y = pk2(acc[m][n][2], acc[m][n][3]);
                    if (c == 255) { o.x = 0u; o.y = 0u; }
                    *(u32x2*)(dst + ((size_t)bh * 256 + c) * 64 + 16 * n + 4 * q) = o;
                }
            }
        }
    }
}

constexpr int AT_LD = 72;
constexpr int AT_TILE = 64 * AT_LD * 2;
constexpr int AT_IMP = 8 * AT_TILE, AT_SELM = AT_IMP + 4 * 64 * 64 * 4, AT_END = AT_SELM + 512;
#define AT_KBUF(lds, slot) ((LAS bf16*)((lds) + (slot) * 2 * AT_TILE))
#define AT_VBUF(lds, slot) ((LAS bf16*)((lds) + (slot) * 2 * AT_TILE + AT_TILE))
static_assert(AT_END <= LDS_JOB, "attention LDS map");
struct AttnAcc { f32x4 o[4][2]; f32x4 ls[2]; float m[2], l[2]; };
__device__ __forceinline__ float attn_rowsum(const AttnAcc& st, int qs);

__device__ __forceinline__ u32x4 tile_fetch(const bf16* __restrict__ src  , int tid) { return *(const u32x4*)(src + (size_t)tid * 8); }
__device__ __forceinline__ void tile_commit(LAS bf16* dst, const u32x4 v, int tid) { *(LAS u32x4*)(dst + (tid >> 3) * AT_LD + (tid & 7) * 8) = v; }
__device__ __forceinline__ void load_qfrag(bf16x8 (&qf)[2][2], const bf16* __restrict__ qbase  , int lane) {
    const int fr = lane & 15, q = lane >> 4;
#pragma unroll
    for (int qs = 0; qs < 2; ++qs)
#pragma unroll
        for (int kk = 0; kk < 2; ++kk) qf[qs][kk] = *(const bf16x8*)(qbase + (size_t)(16 * qs + fr) * 64 + 32 * kk + 8 * q);
}
__device__ __forceinline__ void qk_tile(const LAS bf16* Ks, const bf16x8 (&qf)[2][2], f32x4 (&s)[4][2], int lane) {
    const int fr = lane & 15, q = lane >> 4;
#pragma unroll
    for (int ks = 0; ks < 4; ++ks) {
        s[ks][0] = (f32x4){0.f, 0.f, 0.f, 0.f}; s[ks][1] = (f32x4){0.f, 0.f, 0.f, 0.f};
#pragma unroll
        for (int kk = 0; kk < 2; ++kk) {
            const bf16x8 kf = *(const LAS bf16x8*)(Ks + (16 * ks + fr) * AT_LD + 32 * kk + 8 * q);
            s[ks][0] = __builtin_amdgcn_mfma_f32_16x16x32_bf16(kf, qf[0][kk], s[ks][0], 0, 0, 0);
            s[ks][1] = __builtin_amdgcn_mfma_f32_16x16x32_bf16(kf, qf[1][kk], s[ks][1], 0, 0, 0);
        }
    }
}
typedef short v4i16_t __attribute__((ext_vector_type(4)));
__device__ __forceinline__ void pv_tile(LAS bf16* Vs, const f32x4 (&p)[4][2], f32x4 (&o)[4][2], int lane) {
    const int fr = lane & 15, q = lane >> 4;
    bf16x8 pf[2][2];
#pragma unroll
    for (int qs = 0; qs < 2; ++qs)
#pragma unroll
        for (int kp = 0; kp < 2; ++kp) {
            u32x4 t; t.x = pk2(p[2 * kp][qs][0], p[2 * kp][qs][1]); t.y = pk2(p[2 * kp][qs][2], p[2 * kp][qs][3]);
            t.z = pk2(p[2 * kp + 1][qs][0], p[2 * kp + 1][qs][1]); t.w = pk2(p[2 * kp + 1][qs][2], p[2 * kp + 1][qs][3]);
            pf[qs][kp] = __builtin_bit_cast(bf16x8, t);
        }
    __builtin_amdgcn_sched_barrier(0);
#pragma unroll
    for (int ds = 0; ds < 4; ++ds)
#pragma unroll
        for (int kp = 0; kp < 2; ++kp) {
            const v4i16_t lo = __builtin_amdgcn_ds_read_tr16_b64_v4i16((LAS v4i16_t*)(Vs + (32 * kp + 4 * q + (fr >> 2)) * AT_LD + 16 * ds + 4 * (fr & 3)));
            const v4i16_t hi = __builtin_amdgcn_ds_read_tr16_b64_v4i16((LAS v4i16_t*)(Vs + (32 * kp + 16 + 4 * q + (fr >> 2)) * AT_LD + 16 * ds + 4 * (fr & 3)));
            const bf16x8 vf = __builtin_shufflevector(lo, hi, 0, 1, 2, 3, 4, 5, 6, 7);
            o[ds][0] = __builtin_amdgcn_mfma_f32_16x16x32_bf16(vf, pf[0][kp], o[ds][0], 0, 0, 0);
            o[ds][1] = __builtin_amdgcn_mfma_f32_16x16x32_bf16(vf, pf[1][kp], o[ds][1], 0, 0, 0);
        }
    __builtin_amdgcn_sched_barrier(0);
}
__device__ __forceinline__ float max2f(float a, float b) { float r; asm("v_max_f32_e32 %0, %1, %2" : "=v"(r) : "v"(a), "v"(b)); return r; }
__device__ __forceinline__ float max3f(float a, float b, float c) { float r; asm("v_max3_f32 %0, %1, %2, %3" : "=v"(r) : "v"(a), "v"(b), "v"(c)); return r; }
__device__ __forceinline__ float quad_max(float x) {
    const unsigned u = __float_as_uint(x);
    const auto r = __builtin_amdgcn_permlane16_swap(u, u, false, false);
    const unsigned v = __float_as_uint(max2f(__uint_as_float(r[0]), __uint_as_float(r[1])));
    const auto r2 = __builtin_amdgcn_permlane32_swap(v, v, false, false);
    return max2f(__uint_as_float(r2[0]), __uint_as_float(r2[1]));
}
template <class MaskF>
__device__ __forceinline__ void softmax_tile(f32x4 (&s)[4][2], AttnAcc& st, int lane, int key0, int qtok0, MaskF mask, bool rescale_o) {
    const int fr = lane & 15, q = lane >> 4;
#pragma unroll
    for (int qs = 0; qs < 2; ++qs) {
        const int qtok = qtok0 + 16 * qs + fr;
        float mx = -1e30f;
#pragma unroll
        for (int ks = 0; ks < 4; ++ks)
#pragma unroll
            for (int r = 0; r < 4; ++r) {
                const int key = key0 + 16 * ks + 4 * q + r;
                const float v = mask(qtok, key) ? s[ks][qs][r] : -1e30f;
                s[ks][qs][r] = v; mx = fmaxf(mx, v);
            }
        mx = quad_max(mx);
        const float mnew = fmaxf(st.m[qs], mx);
        const float alpha = __builtin_amdgcn_exp2f(st.m[qs] - mnew);
        float sum = 0.f;
#pragma unroll
        for (int ks = 0; ks < 4; ++ks)
#pragma unroll
            for (int r = 0; r < 4; ++r) {
                const float v = s[ks][qs][r];
                const float p = (v > -1e29f) ? __builtin_amdgcn_exp2f(v - mnew) : 0.f;
                s[ks][qs][r] = p; sum += p;
            }
        st.l[qs] = st.l[qs] * alpha + sum; st.m[qs] = mnew;
        if (rescale_o) {
            st.ls[qs] = st.ls[qs] * alpha;
#pragma unroll
            for (int ds = 0; ds < 4; ++ds) st.o[ds][qs] = st.o[ds][qs] * alpha;
        }
    }
}
__device__ __forceinline__ void attn_tile_fast(AttnAcc& st, const bf16x8 (&qf)[2][2], const LAS bf16* Ks, LAS bf16* Vs, bool ok0, bool ok1, int lane) {
    const int fr = lane & 15, q = lane >> 4;
    float mu[2]; bool un[2]; f32x4 c4[2];
#pragma unroll
    for (int qs = 0; qs < 2; ++qs) {
        const bool ok = qs ? ok1 : ok0;
        un[qs] = st.m[qs] < -1e29f; mu[qs] = un[qs] ? 0.f : st.m[qs];
        const float c = ok ? -mu[qs] : -1e30f;
        c4[qs] = (f32x4){c, c, c, c};
    }
    f32x4 s[4][2];
#pragma unroll
    for (int ks = 0; ks < 4; ++ks) {
        const bf16x8 kf0 = *(const LAS bf16x8*)(Ks + (16 * ks + fr) * AT_LD + 8 * q), kf1 = *(const LAS bf16x8*)(Ks + (16 * ks + fr) * AT_LD + 32 + 8 * q);
        s[ks][0] = __builtin_amdgcn_mfma_f32_16x16x32_bf16(kf0, qf[0][0], c4[0], 0, 0, 0);
        s[ks][1] = __builtin_amdgcn_mfma_f32_16x16x32_bf16(kf0, qf[1][0], c4[1], 0, 0, 0);
        s[ks][0] = __builtin_amdgcn_mfma_f32_16x16x32_bf16(kf1, qf[0][1], s[ks][0], 0, 0, 0);
        s[ks][1] = __builtin_amdgcn_mfma_f32_16x16x32_bf16(kf1, qf[1][1], s[ks][1], 0, 0, 0);
    }
    float mx[2]; bool rec[2];
#pragma unroll
    for (int qs = 0; qs < 2; ++qs) {
        float m = max3f(s[0][qs][0], s[0][qs][1], s[0][qs][2]);
        m = max3f(m, s[0][qs][3], s[1][qs][0]); m = max3f(m, s[1][qs][1], s[1][qs][2]); m = max3f(m, s[1][qs][3], s[2][qs][0]);
        m = max3f(m, s[2][qs][1], s[2][qs][2]); m = max3f(m, s[2][qs][3], s[3][qs][0]); m = max3f(m, s[3][qs][1], s[3][qs][2]);
        m = max2f(m, s[3][qs][3]);
        mx[qs] = quad_max(m);
        const bool ok = qs ? ok1 : ok0;
        rec[qs] = ok & ((mx[qs] > 8.0f) | (un[qs] & (mx[qs] < -8.0f)));
    }
    if (__any(rec[0] || rec[1])) {
        asm volatile("" ::: "memory");
#pragma unroll
        for (int qs = 0; qs < 2; ++qs) {
            const float d = rec[qs] ? mx[qs] : 0.f, alpha = un[qs] ? 1.0f : __builtin_amdgcn_exp2f(-d);
#pragma unroll
            for (int ks = 0; ks < 4; ++ks) s[ks][qs] = s[ks][qs] - d;
            mu[qs] += d; st.l[qs] *= alpha; st.ls[qs] = st.ls[qs] * alpha;
#pragma unroll
            for (int ds = 0; ds < 4; ++ds) st.o[ds][qs] = st.o[ds][qs] * alpha;
        }
    }
#pragma unroll
    for (int qs = 0; qs < 2; ++qs) {
        const bool ok = qs ? ok1 : ok0;
        st.m[qs] = ok ? mu[qs] : st.m[qs];
#pragma unroll
        for (int ks = 0; ks < 4; ++ks)
#pragma unroll
            for (int r = 0; r < 4; ++r) s[ks][qs][r] = __builtin_amdgcn_exp2f(s[ks][qs][r]);
    }
    bf16x8 pf[2][2];
#pragma unroll
    for (int qs = 0; qs < 2; ++qs)
#pragma unroll
        for (int kp = 0; kp < 2; ++kp) {
            u32x4 t; t.x = pk2(s[2 * kp][qs][0], s[2 * kp][qs][1]); t.y = pk2(s[2 * kp][qs][2], s[2 * kp][qs][3]);
            t.z = pk2(s[2 * kp + 1][qs][0], s[2 * kp + 1][qs][1]); t.w = pk2(s[2 * kp + 1][qs][2], s[2 * kp + 1][qs][3]);
            pf[qs][kp] = __builtin_bit_cast(bf16x8, t);
        }
    const unsigned one2 = (fr == 0) ? 0x3F803F80u : 0u;
    const bf16x8 onesf = __builtin_bit_cast(bf16x8, (u32x4){one2, one2, one2, one2});
#pragma unroll
    for (int kp = 0; kp < 2; ++kp) {
        st.ls[0] = __builtin_amdgcn_mfma_f32_16x16x32_bf16(onesf, pf[0][kp], st.ls[0], 0, 0, 0);
        st.ls[1] = __builtin_amdgcn_mfma_f32_16x16x32_bf16(onesf, pf[1][kp], st.ls[1], 0, 0, 0);
    }
    __builtin_amdgcn_sched_barrier(0);
#pragma unroll
    for (int ds = 0; ds < 4; ++ds)
#pragma unroll
        for (int kp = 0; kp < 2; ++kp) {
            const v4i16_t lo = __builtin_amdgcn_ds_read_tr16_b64_v4i16((LAS v4i16_t*)(Vs + (32 * kp + 4 * q + (fr >> 2)) * AT_LD + 16 * ds + 4 * (fr & 3)));
            const v4i16_t hi = __builtin_amdgcn_ds_read_tr16_b64_v4i16((LAS v4i16_t*)(Vs + (32 * kp + 16 + 4 * q + (fr >> 2)) * AT_LD + 16 * ds + 4 * (fr & 3)));
            const bf16x8 vf = __builtin_shufflevector(lo, hi, 0, 1, 2, 3, 4, 5, 6, 7);
            st.o[ds][0] = __builtin_amdgcn_mfma_f32_16x16x32_bf16(vf, pf[0][kp], st.o[ds][0], 0, 0, 0);
            st.o[ds][1] = __builtin_amdgcn_mfma_f32_16x16x32_bf16(vf, pf[1][kp], st.o[ds][1], 0, 0, 0);
        }
    __builtin_amdgcn_sched_barrier(0);
}
__device__ __forceinline__ void attn_init(AttnAcc& st) {
#pragma unroll
    for (int ds = 0; ds < 4; ++ds) { st.o[ds][0] = (f32x4){0.f, 0.f, 0.f, 0.f}; st.o[ds][1] = (f32x4){0.f, 0.f, 0.f, 0.f}; }
    st.m[0] = st.m[1] = -1e30f; st.l[0] = st.l[1] = 0.f; st.ls[0] = st.ls[1] = (f32x4){0.f, 0.f, 0.f, 0.f};
}
__device__ __forceinline__ float quad_sum(float v) { v += __shfl_xor(v, 16); v += __shfl_xor(v, 32); return v; }
__device__ __forceinline__ float attn_rowsum(const AttnAcc& st, int qs) { return quad_sum(st.l[qs] + ((st.ls[qs][0] + st.ls[qs][1]) + (st.ls[qs][2] + st.ls[qs][3]))); }

__device__ __forceinline__ void banded_tile(AttnAcc& st, const bf16x8 (&qf)[2][2], LAS unsigned char* lds, int slot, int kt, int i, int window, int qtok0, int lane) {
    if (kt < i && (64 * i + 63 - 64 * kt) < window) { attn_tile_fast(st, qf, AT_KBUF(lds, slot), AT_VBUF(lds, slot), true, true, lane); return; }
    f32x4 s[4][2];
    qk_tile(AT_KBUF(lds, slot), qf, s, lane);
    softmax_tile(s, st, lane, kt * 64, qtok0, [window](int qt, int key) { const int d = qt - key; return d >= 0 && d < window; }, true);
    pv_tile(AT_VBUF(lds, slot), s, st.o, lane);
}
__device__ __forceinline__ void banded_attn(AttnAcc& st, const bf16x8 (&qf)[2][2], const bf16* __restrict__ Kb, const bf16* __restrict__ Vb,
                                            int i, int ntile_back, int window, int qtok0, LAS unsigned char* lds, int tid) {
    const int lane = tid & 63;
    const int kt0 = (i - ntile_back) > 0 ? (i - ntile_back) : 0;
    u32x4 rk, rv;
    rk = tile_fetch(Kb + (size_t)kt0 * 4096, tid); rv = tile_fetch(Vb + (size_t)kt0 * 4096, tid);
    tile_commit(AT_KBUF(lds, 0), rk, tid); tile_commit(AT_VBUF(lds, 0), rv, tid);
    if (kt0 + 1 <= i) { rk = tile_fetch(Kb + (size_t)(kt0 + 1) * 4096, tid); rv = tile_fetch(Vb + (size_t)(kt0 + 1) * 4096, tid);
                        tile_commit(AT_KBUF(lds, 1), rk, tid); tile_commit(AT_VBUF(lds, 1), rv, tid); }
    __syncthreads();
    for (int kt = kt0, buf = 0; kt <= i; kt += 2, buf ^= 1) {
        const bool n0 = kt + 2 <= i, n1 = kt + 3 <= i;
        if (n0) { rk = tile_fetch(Kb + (size_t)(kt + 2) * 4096, tid); rv = tile_fetch(Vb + (size_t)(kt + 2) * 4096, tid); }
        banded_tile(st, qf, lds, 2 * buf, kt, i, window, qtok0, lane);
        if (n0) { tile_commit(AT_KBUF(lds, 2 * (buf ^ 1)), rk, tid); tile_commit(AT_VBUF(lds, 2 * (buf ^ 1)), rv, tid); }
        if (n1) { rk = tile_fetch(Kb + (size_t)(kt + 3) * 4096, tid); rv = tile_fetch(Vb + (size_t)(kt + 3) * 4096, tid); }
        if (kt + 1 <= i) banded_tile(st, qf, lds, 2 * buf + 1, kt + 1, i, window, qtok0, lane);
        if (n1) { tile_commit(AT_KBUF(lds, 2 * (buf ^ 1) + 1), rk, tid); tile_commit(AT_VBUF(lds, 2 * (buf ^ 1) + 1), rv, tid); }
        __syncthreads();
    }
}

__device__ __forceinline__ void store_mixed(bf16* __restrict__ MIX, const f32x4 (&o)[4][2], int b, int t0w, int col0, int lane) {
    const int fr = lane & 15, q = lane >> 4;
#pragma unroll
    for (int qs = 0; qs < 2; ++qs) {
        const size_t row = (size_t)b * T + t0w + 16 * qs + fr;
#pragma unroll
        for (int ds = 0; ds < 4; ++ds) {
            u32x2 w; w.x = pk2(o[ds][qs][0], o[ds][qs][1]); w.y = pk2(o[ds][qs][2], o[ds][qs][3]);
            *(u32x2*)(MIX + row * D + col0 + 16 * ds + 4 * q) = w;
        }
    }
}

__device__ __forceinline__ void swa_unit(const Args& a, LAS unsigned char* lds, int tid, int b, int kvh, int i) {
    unsigned char* ws = a.ws;
    const int lane = tid & 63, w = tid >> 6, g = w >> 1, head = 4 * kvh + g, t0w = 64 * i + 32 * (w & 1);
    const bf16* Qh = (const bf16*)(ws + WS_Q) + ((size_t)(b * 16 + head) * T + t0w) * 64;
    const bf16* Kb = (const bf16*)(ws + WS_KV) + 0 * KV_TENSOR + (size_t)(b * 2 + kvh) * T * 64;
    const bf16* Vb = (const bf16*)(ws + WS_KV) + 1 * KV_TENSOR + (size_t)(b * 2 + kvh) * T * 64;
    bf16x8 qf[2][2]; load_qfrag(qf, Qh, lane);
    AttnAcc st; attn_init(st);
    const float sink = ((const float*)a.in[I_SINKS])[head];
    st.m[0] = st.m[1] = sink * 1.4426950408889634f; st.l[0] = st.l[1] = (lane < 16) ? 1.f : 0.f;
    banded_attn(st, qf, Kb, Vb, i, 2, 128, t0w, lds, tid);
#pragma unroll
    for (int qs = 0; qs < 2; ++qs) {
        const float inv = 1.0f / attn_rowsum(st, qs);
#pragma unroll
        for (int ds = 0; ds < 4; ++ds) st.o[ds][qs] = st.o[ds][qs] * inv;
    }
    store_mixed((bf16*)(ws + WS_MIXED), st.o, b, t0w, head * 64, lane);
}

__device__ __forceinline__ void nsa_unit(const Args& a, LAS unsigned char* lds, int tid, int b, int kvh, int i) {
    unsigned char* ws = a.ws;
    const int lane = tid & 63, w = tid >> 6, g = w >> 1, head = 4 * kvh + g, t0 = 64 * i, t0w = t0 + 32 * (w & 1), fr = lane & 15, q = lane >> 4;
    const int bh = b * 2 + kvh;
    LAS float* imp = (LAS float*)(lds + AT_IMP);
    LAS unsigned* selm = (LAS unsigned*)(lds + AT_SELM);
    const bf16* Qh = (const bf16*)(ws + WS_Q) + ((size_t)(b * 16 + 8 + head) * T + t0w) * 64;
    bf16x8 qf[2][2]; load_qfrag(qf, Qh, lane);
    const float* G = (const float*)(ws + WS_GATES);
    AttnAcc st;
    LAS float* OF = (LAS float*)(lds + AT_IMP) + w * 2048;

    const bf16* KC = (const bf16*)(ws + WS_KCMP) + (size_t)bh * 256 * 64;
    const bf16* VC = (const bf16*)(ws + WS_VCMP) + (size_t)bh * 256 * 64;
    const int cmax = (t0 + 63 - 31) >> 4, nct = cmax / 64 + 1;
    auto vis = [](int qt, int c) { return 16 * c + 31 <= qt; };
    u32x4 rk, rv;
    {
        u32x4 rkc[4], rvc[4];
#pragma unroll
        for (int ct = 0; ct < 4; ++ct) if (ct < nct) { rkc[ct] = tile_fetch(KC + (size_t)ct * 4096, tid); rvc[ct] = tile_fetch(VC + (size_t)ct * 4096, tid); }
#pragma unroll
        for (int ct = 0; ct < 4; ++ct) if (ct < nct) { tile_commit(AT_KBUF(lds, ct), rkc[ct], tid); tile_commit(AT_VBUF(lds, ct), rvc[ct], tid); }
    }
    __syncthreads();
    attn_init(st);
    for (int ct = 0; ct < nct; ++ct) {
        f32x4 s[4][2];
        qk_tile(AT_KBUF(lds, ct), qf, s, lane);
        softmax_tile(s, st, lane, ct * 64, t0w, vis, false);
    }
    float linv[2];
#pragma unroll
    for (int qs = 0; qs < 2; ++qs) { const float l = quad_sum(st.l[qs]); linv[qs] = l > 0.f ? 1.0f / l : 0.f; }
    float carry[2] = {0.f, 0.f};
    for (int ct = 0; ct < nct; ++ct) {
        f32x4 s[4][2];
        qk_tile(AT_KBUF(lds, ct), qf, s, lane);
#pragma unroll
        for (int qs = 0; qs < 2; ++qs) {
            const int qtok = t0w + 16 * qs + fr;
#pragma unroll
            for (int ks = 0; ks < 4; ++ks)
#pragma unroll
                for (int r = 0; r < 4; ++r) {
                    const int c = ct * 64 + 16 * ks + 4 * q + r;
                    s[ks][qs][r] = vis(qtok, c) ? __builtin_amdgcn_exp2f(s[ks][qs][r] - st.m[qs]) * linv[qs] : 0.f;
                }
            const int tokl = 32 * (w & 1) + 16 * qs + fr;
#pragma unroll
            for (int ks = 0; ks < 4; ++ks) {
                const float p3 = s[ks][qs][3];
                const float fromq = __shfl(p3, (lane + 48) & 63);
                const float prevk = (ks == 0) ? carry[qs] : s[ks > 0 ? ks - 1 : 0][qs][3];
                const float fromk = __shfl(prevk, (lane + 48) & 63);
                const float prev = (q > 0) ? fromq : fromk;
                const int j = ct * 16 + 4 * ks + q;
                imp[(g * 64 + tokl) * 64 + j] = (s[ks][qs][0] + s[ks][qs][1]) + (s[ks][qs][2] + 0.5f * p3) + 0.5f * prev;
            }
            carry[qs] = s[3][qs][3];
        }
        pv_tile(AT_VBUF(lds, ct), s, st.o, lane);
    }
    __syncthreads();
    {
        const int cur = i, j = lane;
        const bool valid = j <= cur, forced = (j == 0) || (j == cur) || (j == cur - 1);
        unsigned key[8], srt[8];
#pragma unroll
        for (int tt = 0; tt < 8; ++tt) {
            const int tokl = 8 * w + tt;
            unsigned k_ = 0u;
            if (valid && !forced) { const float sc = (imp[(0 * 64 + tokl) * 64 + j] + imp[(1 * 64 + tokl) * 64 + j]) + (imp[(2 * 64 + tokl) * 64 + j] + imp[(3 * 64 + tokl) * 64 + j]);
                                    k_ = ((__float_as_uint(sc) | 0x80000000u) & 0xFFFFFFC0u) | (unsigned)(63 - j); }
            if (valid && forced) k_ = 0xFFFFFFC0u | (unsigned)(63 - j);
            key[tt] = k_; srt[tt] = k_;
        }
#pragma unroll
        for (int k = 2; k <= 64; k <<= 1)
#pragma unroll
            for (int jj = k >> 1; jj >= 1; jj >>= 1) {
                const bool keepmax = ((lane & jj) == 0) == ((lane & k) == 0);
#pragma unroll
                for (int tt = 0; tt < 8; ++tt) {
                    const unsigned o = (unsigned)__shfl_xor((int)srt[tt], jj);
                    const unsigned mx = __builtin_elementwise_max(srt[tt], o), mn = __builtin_elementwise_min(srt[tt], o);
                    srt[tt] = keepmax ? mx : mn;
                }
            }
#pragma unroll
        for (int tt = 0; tt < 8; ++tt) {
            const unsigned thr = (unsigned)__builtin_amdgcn_readlane((int)srt[tt], 15);
            const bool sel = (key[tt] >= thr) && (key[tt] != 0u);
            const unsigned long long bm = __ballot(sel);
            if (lane == 0) { selm[(8 * w + tt) * 2] = (unsigned)bm; selm[(8 * w + tt) * 2 + 1] = (unsigned)(bm >> 32); }
        }
    }
    __syncthreads();
    unsigned long long uni;
    {
        unsigned lo = selm[lane * 2], hi = selm[lane * 2 + 1];
#pragma unroll
        for (int o = 1; o < 64; o <<= 1) { lo |= __shfl_xor(lo, o); hi |= __shfl_xor(hi, o); }
        uni = ((unsigned long long)(unsigned)__builtin_amdgcn_readfirstlane((int)hi) << 32) | (unsigned)__builtin_amdgcn_readfirstlane((int)lo);
    }
    unsigned long long qm[2];
#pragma unroll
    for (int qs = 0; qs < 2; ++qs) { const int tokl = 32 * (w & 1) + 16 * qs + fr; qm[qs] = ((unsigned long long)selm[tokl * 2 + 1] << 32) | selm[tokl * 2]; }
    __syncthreads();
#pragma unroll
    for (int qs = 0; qs < 2; ++qs) {
        const float g0 = G[((size_t)b * T + t0w + 16 * qs + fr) * 24 + head * 3 + 0];
#pragma unroll
        for (int ds = 0; ds < 4; ++ds)
#pragma unroll
            for (int r = 0; r < 4; ++r) OF[((ds * 2 + qs) * 4 + r) * 64 + lane] = st.o[ds][qs][r] * g0;
    }

    {
        const bf16* Kb = (const bf16*)(ws + WS_KV) + 4 * KV_TENSOR + (size_t)bh * T * 64;
        const bf16* Vb = (const bf16*)(ws + WS_KV) + 5 * KV_TENSOR + (size_t)bh * T * 64;
        attn_init(st);
        unsigned long long rem = uni;
        const int tbase = t0w + fr;
#define sel_tile(slot, j) { const unsigned b0 = (unsigned)((qm[0] >> (j)) & 1ull), b1 = (unsigned)((qm[1] >> (j)) & 1ull); \
            if ((j) < i) attn_tile_fast(st, qf, AT_KBUF(lds, slot), AT_VBUF(lds, slot), b0 != 0u, b1 != 0u, lane); \
            else { f32x4 s[4][2]; qk_tile(AT_KBUF(lds, slot), qf, s, lane); \
                   softmax_tile(s, st, lane, (j) * 64, t0w, [b0, b1, tbase](int qt, int key) { const unsigned bit = (qt - tbase) >= 16 ? b1 : b0; return bit != 0u && key <= qt; }, true); \
                   pv_tile(AT_VBUF(lds, slot), s, st.o, lane); } }
        int j0 = (int)__builtin_ctzll(rem); rem &= rem - 1;
        int j1 = rem ? (int)__builtin_ctzll(rem) : -1; if (j1 >= 0) rem &= rem - 1;
        rk = tile_fetch(Kb + (size_t)j0 * 4096, tid); rv = tile_fetch(Vb + (size_t)j0 * 4096, tid);
        tile_commit(AT_KBUF(lds, 0), rk, tid); tile_commit(AT_VBUF(lds, 0), rv, tid);
        if (j1 >= 0) { rk = tile_fetch(Kb + (size_t)j1 * 4096, tid); rv = tile_fetch(Vb + (size_t)j1 * 4096, tid);
                       tile_commit(AT_KBUF(lds, 1), rk, tid); tile_commit(AT_VBUF(lds, 1), rv, tid); }
        __syncthreads();
        for (int buf = 0;; buf ^= 1) {
            const int n0 = rem ? (int)__builtin_ctzll(rem) : -1; if (n0 >= 0) rem &= rem - 1;
            const int n1 = rem ? (int)__builtin_ctzll(rem) : -1; if (n1 >= 0) rem &= rem - 1;
            if (n0 >= 0) { rk = tile_fetch(Kb + (size_t)n0 * 4096, tid); rv = tile_fetch(Vb + (size_t)n0 * 4096, tid); }
            sel_tile(2 * buf, j0)
            if (n0 >= 0) { tile_commit(AT_KBUF(lds, 2 * (buf ^ 1)), rk, tid); tile_commit(AT_VBUF(lds, 2 * (buf ^ 1)), rv, tid); }
            if (n1 >= 0) { rk = tile_fetch(Kb + (size_t)n1 * 4096, tid); rv = tile_fetch(Vb + (size_t)n1 * 4096, tid); }
            if (j1 >= 0) sel_tile(2 * buf + 1, j1)
            if (n1 >= 0) { tile_commit(AT_KBUF(lds, 2 * (buf ^ 1) + 1), rk, tid); tile_commit(AT_VBUF(lds, 2 * (buf ^ 1) + 1), rv, tid); }
            __syncthreads();
            if (n0 < 0) break;
            j0 = n0; j1 = n1;
        }
#undef sel_tile
#pragma unroll
        for (int qs = 0; qs < 2; ++qs) {
            const float g1 = G[((size_t)b * T + t0w + 16 * qs + fr) * 24 + head * 3 + 1];
            const float sc = g1 / attn_rowsum(st, qs);
#pragma unroll
            for (int ds = 0; ds < 4; ++ds)
#pragma unroll
                for (int r = 0; r < 4; ++r) OF[((ds * 2 + qs) * 4 + r) * 64 + lane] += st.o[ds][qs][r] * sc;
        }
    }
    {
        const bf16* Kb = (const bf16*)(ws + WS_KV) + 6 * KV_TENSOR + (size_t)bh * T * 64;
        const bf16* Vb = (const bf16*)(ws + WS_KV) + 7 * KV_TENSOR + (size_t)bh * T * 64;
        attn_init(st);
        banded_attn(st, qf, Kb, Vb, i, 8, 512, t0w, lds, tid);
#pragma unroll
        for (int qs = 0; qs < 2; ++qs) {
            const float g2 = G[((size_t)b * T + t0w + 16 * qs + fr) * 24 + head * 3 + 2];
            const float sc = g2 / attn_rowsum(st, qs);
#pragma unroll
            for (int ds = 0; ds < 4; ++ds)
#pragma unroll
                for (int r = 0; r < 4; ++r) st.o[ds][qs][r] = OF[((ds * 2 + qs) * 4 + r) * 64 + lane] + st.o[ds][qs][r] * sc;
        }
    }
    store_mixed((bf16*)(ws + WS_MIXED), st.o, b, t0w, 512 + head * 64, lane);
    __syncthreads();
}

__device__ __forceinline__ void phase4(const Args& a, LAS unsigned char* lds, int tid) {
    for (int u = blockIdx.x; u < 2048; u += gridDim.x) {
        if (u < 1024) {
            const int bh = u & 15, x = (u >> 4) & 15, r = u >> 8;
            const int i = (r == 0) ? x : (r == 1) ? 63 - x : (r == 2) ? 16 + x : 47 - x;
            nsa_unit(a, lds, tid, bh >> 1, bh & 1, i);
        } else {
            const int v = u - 1024, bh = v & 15, i = v >> 4;
            swa_unit(a, lds, tid, bh >> 1, bh & 1, i);
        }
    }
}

struct EpiOutProj {
    static constexpr bool PERM = false, AFTER_DRAIN = false;
    const float* X; bf16* XB; float* SSP; float* AMP;
    __device__ __forceinline__ void operator()(const f32x4 (&acc)[2][2][4][2], const pg8::Unit& u, int wr, int wc, int fr, int fq) const {
#pragma unroll
        for (int ai = 0; ai < 2; ++ai)
#pragma unroll
            for (int m = 0; m < 4; ++m) {
                const size_t row = (size_t)u.pm * 256 + 128 * ai + 64 * wr + 16 * m + fr;
                float ss = 0.f, am = 0.f;
#pragma unroll
                for (int bj = 0; bj < 2; ++bj)
#pragma unroll
                    for (int n = 0; n < 2; ++n) {
                        const size_t off = row * D + u.pn * 256 + 128 * bj + 32 * wc + 16 * n + 4 * fq;
                        const f32x4 v = *(const f32x4*)(X + off) + acc[ai][bj][m][n];
                        u32x2 o; o.x = pk2(v[0], v[1]); o.y = pk2(v[2], v[3]);
                        *(u32x2*)(XB + off) = o;
                        ss += (v[0] * v[0] + v[1] * v[1]) + (v[2] * v[2] + v[3] * v[3]);
                        am = fmaxf(am, fmaxf(fmaxf(fabsf(v[0]), fabsf(v[1])), fmaxf(fabsf(v[2]), fabsf(v[3]))));
                    }
                ss += __shfl_xor(ss, 16); ss += __shfl_xor(ss, 32);
                am = fmaxf(am, __shfl_xor(am, 16)); am = fmaxf(am, __shfl_xor(am, 32));
                if (fq == 0) { SSP[row * 16 + u.pn * 4 + wc] = ss; AMP[row * 16 + u.pn * 4 + wc] = am; }
            }
    }
};
__device__ __forceinline__ void phase5(const Args& a, LAS unsigned char* lds, int tid) {
    unsigned char* ws = a.ws;
    pg8::Gemm g{(const bf16*)(ws + WS_MIXED), (const bf16*)(ws + WS_WOUT_T), NTOK, D, D};
    pg8::StaticOrder S; S.init(NTOK, D, (int)gridDim.x, (int)blockIdx.x);
    EpiOutProj E{(const float*)a.in[I_X], (bf16*)(ws + WS_H), (float*)(ws + WS_SSP), (float*)(ws + WS_AMP)};
    pg8::gemm_phase<EpiOutProj, pg8::StaticOrder, true, true>(lds, g, S, E);
}

struct EpiPeerQ {
    static constexpr bool PERM = true, AFTER_DRAIN = false;
    bf16* PQ; const float* SSP; const float* AMP; float* R2; float* AMAX;
    __device__ __forceinline__ void operator()(const f32x4 (&acc)[2][2][4][2], const pg8::Unit& u, int wr, int wc, int fr, int fq) const {
#pragma unroll
        for (int ai = 0; ai < 2; ++ai)
#pragma unroll
            for (int m = 0; m < 4; ++m) {
                const size_t row = (size_t)u.pm * 256 + 128 * ai + 64 * wr + 16 * m + fr;
                const f32x4 p0 = *(const f32x4*)(SSP + row * 16), p1 = *(const f32x4*)(SSP + row * 16 + 4), p2 = *(const f32x4*)(SSP + row * 16 + 8), p3 = *(const f32x4*)(SSP + row * 16 + 12);
                const f32x4 ps = (p0 + p1) + (p2 + p3);
                const float r = rsqrtf(((ps[0] + ps[1]) + (ps[2] + ps[3])) * (1.0f / D) + RMS_EPS);
                if (u.pn == 0 && wc == 0 && fq == 0) {
                    const f32x4 a0 = *(const f32x4*)(AMP + row * 16), a1 = *(const f32x4*)(AMP + row * 16 + 4), a2 = *(const f32x4*)(AMP + row * 16 + 8), a3 = *(const f32x4*)(AMP + row * 16 + 12);
                    const f32x4 mm = __builtin_elementwise_max(__builtin_elementwise_max(a0, a1), __builtin_elementwise_max(a2, a3));
                    R2[row] = r; AMAX[row] = fmaxf(fmaxf(mm[0], mm[1]), fmaxf(mm[2], mm[3]));
                }
#pragma unroll
                for (int bj = 0; bj < 2; ++bj) {
                    const f32x4 v0 = acc[ai][bj][m][0] * r, v1 = acc[ai][bj][m][1] * r;
                    u32x4 w; w.x = pk2(v0[0], v0[1]); w.y = pk2(v0[2], v0[3]); w.z = pk2(v1[0], v1[1]); w.w = pk2(v1[2], v1[3]);
                    *(u32x4*)(PQ + row * 2048 + u.pn * 256 + 128 * bj + 32 * wc + 8 * fq) = w;
                }
            }
    }
};
__device__ __forceinline__ void phase6(const Args& a, LAS unsigned char* lds, int tid) {
    unsigned char* ws = a.ws;
    pg8::Gemm g{(const bf16*)(ws + WS_H), (const bf16*)(ws + WS_WQ_T), NTOK, 2048, D};
    pg8::StaticOrder S; S.init(NTOK, 2048, (int)gridDim.x, (int)blockIdx.x);
    EpiPeerQ E{(bf16*)(ws + WS_PEERQ), (const float*)(ws + WS_SSP), (const float*)(ws + WS_AMP), (float*)(ws + WS_R2), (float*)(ws + WS_AMAX)};
    pg8::gemm_phase<EpiPeerQ, pg8::StaticOrder, true, true>(lds, g, S, E);
}

constexpr int P7_KLD = 136;
constexpr int P7_SK = 0, P7_TL = 2 * 128 * P7_KLD * 2, P7_END = P7_TL + 512 * 32 * 4;
__device__ __forceinline__ unsigned ord_key(float f) { const unsigned u = __float_as_uint(f); return (u & 0x80000000u) ? ~u : (u | 0x80000000u); }
__device__ __forceinline__ float ord_val(unsigned k) { const unsigned u = (k & 0x80000000u) ? (k & 0x7fffffffu) : ~k; return __uint_as_float(u); }
__device__ __forceinline__ void ins16(unsigned (&list)[16], unsigned c) {
#pragma unroll
    for (int k = 0; k < 16; ++k) { const unsigned hi = __builtin_elementwise_max(list[k], c); c = __builtin_elementwise_min(list[k], c); list[k] = hi; }
}
#define P7_CE(v, i, l) { const unsigned a_ = v[i], b_ = v[l]; v[i] = __builtin_elementwise_max(a_, b_); v[l] = __builtin_elementwise_min(a_, b_); }
template <int N> __device__ __forceinline__ void bitonic_sort_desc(unsigned (&v)[N]) {
#pragma unroll
    for (int k = 2; k <= N; k <<= 1)
#pragma unroll
        for (int j = k >> 1; j > 0; j >>= 1)
#pragma unroll
            for (int i = 0; i < N; ++i) { const int l = i ^ j; if (l > i) { if ((i & k) == 0) P7_CE(v, i, l) else P7_CE(v, l, i) } }
}
template <int N> __device__ __forceinline__ void bitonic_merge_desc(unsigned (&v)[N]) {
#pragma unroll
    for (int j = N >> 1; j > 0; j >>= 1)
#pragma unroll
        for (int i = 0; i < N; ++i) { const int l = i ^ j; if (l > i) P7_CE(v, i, l) }
}
__device__ __forceinline__ void sort16_desc(unsigned (&v)[16]) { P7_CE(v, 0, 1) P7_CE(v, 2, 3) P7_CE(v, 0, 2) P7_CE(v, 1, 3) P7_CE(v, 1, 2) P7_CE(v, 4, 5) P7_CE(v, 6, 7) P7_CE(v, 4, 6) P7_CE(v, 5, 7) P7_CE(v, 5, 6) P7_CE(v, 0, 4) P7_CE(v, 2, 6) P7_CE(v, 2, 4) P7_CE(v, 1, 5) P7_CE(v, 3, 7) P7_CE(v, 3, 5) P7_CE(v, 1, 2) P7_CE(v, 3, 4) P7_CE(v, 5, 6) P7_CE(v, 8, 9) P7_CE(v, 10, 11) P7_CE(v, 8, 10) P7_CE(v, 9, 11) P7_CE(v, 9, 10) P7_CE(v, 12, 13) P7_CE(v, 14, 15) P7_CE(v, 12, 14) P7_CE(v, 13, 15) P7_CE(v, 13, 14) P7_CE(v, 8, 12) P7_CE(v, 10, 14) P7_CE(v, 10, 12) P7_CE(v, 9, 13) P7_CE(v, 11, 15) P7_CE(v, 11, 13) P7_CE(v, 9, 10) P7_CE(v, 11, 12) P7_CE(v, 13, 14) P7_CE(v, 0, 8) P7_CE(v, 4, 12) P7_CE(v, 4, 8) P7_CE(v, 2, 10) P7_CE(v, 6, 14) P7_CE(v, 6, 10) P7_CE(v, 2, 4) P7_CE(v, 6, 8) P7_CE(v, 10, 12) P7_CE(v, 1, 9) P7_CE(v, 5, 13) P7_CE(v, 5, 9) P7_CE(v, 3, 11) P7_CE(v, 7, 15) P7_CE(v, 7, 11) P7_CE(v, 3, 5) P7_CE(v, 7, 9) P7_CE(v, 11, 13) P7_CE(v, 1, 2) P7_CE(v, 3, 4) P7_CE(v, 5, 6) P7_CE(v, 7, 8) P7_CE(v, 9, 10) P7_CE(v, 11, 12) P7_CE(v, 13, 14) }
__device__ __forceinline__ void top16_desc(unsigned (&t)[16], const unsigned (&o)[16]) {
#pragma unroll
    for (int k = 0; k < 16; ++k) t[k] = __builtin_elementwise_max(t[k], o[15 - k]);
    bitonic_merge_desc<16>(t);
}
__device__ __forceinline__ void phase7(const Args& a, LAS unsigned char* lds, int tid) {
    unsigned char* ws = a.ws;
    const bf16* PQ = (const bf16*)(ws + WS_PEERQ); const bf16* SK = (const bf16*)(ws + WS_SUBK);
    unsigned short* EIDX = (unsigned short*)(ws + WS_EIDX); float* EG = (float*)(ws + WS_EGATE); float* ESDT = (float*)(ws + WS_ESDT);
    const float* ESD = (const float*)(ws + WS_ESD); const float* ESU = (const float*)(ws + WS_ESU);
    LAS bf16* skl = (LAS bf16*)(lds + P7_SK);
    const int lane = tid & 63, w = tid >> 6, fr = lane & 15, q = lane >> 4;
    LAS unsigned* tlw = (LAS unsigned*)(lds + P7_TL) + (size_t)tid * 32;
    {
        const int row = tid >> 1, hf = tid & 1;
#pragma unroll
        for (int c = 0; c < 8; ++c) *(LAS u32x4*)(skl + row * P7_KLD + hf * 64 + c * 8) = *(const u32x4*)(SK + (size_t)row * 128 + hf * 64 + c * 8);
    }
    __syncthreads();
    for (int it = blockIdx.x * 8 + w; it < (NTOK / 16) * 2; it += gridDim.x * 8) {
        const int tok0 = (it >> 1) * 16, quad = it & 1;
        unsigned t1k[16], t2k[16];
#pragma unroll
        for (int k = 0; k < 16; ++k) { t1k[k] = 0u; t2k[k] = 0u; }
        const bf16* qrow0 = PQ + (size_t)(tok0 + fr) * 2048 + (4 * quad) * 256 + 8 * q;
        bf16x8 qn[4];
#pragma unroll
        for (int kk = 0; kk < 4; ++kk) qn[kk] = *(const bf16x8*)(qrow0 + 32 * kk);
#pragma unroll 1
        for (int hh = 0; hh < 8; ++hh) {
            const int hq = hh >> 1, half = hh & 1;
            bf16x8 qf[4];
#pragma unroll
            for (int kk = 0; kk < 4; ++kk) qf[kk] = qn[kk];
            if (hh < 7) {
#pragma unroll
                for (int kk = 0; kk < 4; ++kk) qn[kk] = *(const bf16x8*)(qrow0 + (hh + 1) * 128 + 32 * kk);
            }
            {
                f32x4 acc[8];
#pragma unroll
                for (int n = 0; n < 8; ++n) acc[n] = (f32x4){0.f, 0.f, 0.f, 0.f};
#pragma unroll
                for (int kk = 0; kk < 4; ++kk)
#pragma unroll
                    for (int n = 0; n < 8; ++n) {
                        const bf16x8 kf = *(const LAS bf16x8*)(skl + (half * 128 + 16 * n + fr) * P7_KLD + 32 * kk + 8 * q);
                        acc[n] = __builtin_amdgcn_mfma_f32_16x16x32_bf16(kf, qf[kk], acc[n], 0, 0, 0);
                    }
                unsigned v[32];
#pragma unroll
                for (int n = 0; n < 8; ++n)
#pragma unroll
                    for (int r = 0; r < 4; ++r) v[4 * n + r] = (ord_key(acc[n][r]) & 0xFFFFFF80u) | (unsigned)(127 - (16 * n + 4 * q + r));
                unsigned t[16];
                {
                    unsigned u2[16];
#pragma unroll
                    for (int k = 0; k < 16; ++k) { t[k] = v[k]; u2[k] = v[16 + k]; }
                    sort16_desc(t); sort16_desc(u2); top16_desc(t, u2);
                }
#pragma unroll
                for (int rnd = 0; rnd < 2; ++rnd) {
                    unsigned o[16];
#pragma unroll
                    for (int k = 0; k < 16; ++k) o[k] = (unsigned)__shfl_xor((int)t[15 - k], rnd ? 32 : 16);
#pragma unroll
                    for (int k = 0; k < 16; ++k) t[k] = __builtin_elementwise_max(t[k], o[k]);
                    bitonic_merge_desc<16>(t);
                }
                if (q == hq) {
#pragma unroll
                    for (int k = 0; k < 16; ++k) { if (half == 0) t1k[k] = t[k]; else t2k[k] = t[k]; }
                }
            }
        }
#pragma unroll
        for (int k = 0; k < 16; ++k) { tlw[k] = t1k[k]; tlw[16 + k] = t2k[k]; }
        float t1[16], t2[16];
#pragma unroll
        for (int k = 0; k < 16; ++k) { t1[k] = ord_val(t1k[k] & 0xFFFFFF80u); t2[k] = ord_val(t2k[k] & 0xFFFFFF80u); }
#define P7_KEY(aa, bb) ((ord_key(t1[aa] + t2[bb]) & 0xFFFFFF00u) | (unsigned)(255 - ((aa) * 16 + (bb))))
        unsigned list[16], l1[16], s2[16], s3[16];
#pragma unroll
        for (int k = 0; k < 16; ++k) { list[k] = P7_KEY(0, k); l1[k] = k < 8 ? P7_KEY(1, k) : 0u; }
        top16_desc(list, l1);
        { int n = 0;
#pragma unroll
          for (int aa = 2; aa < 7; ++aa)
#pragma unroll
              for (int bb = 0; bb < 16; ++bb) if ((aa + 1) * (bb + 1) <= 16) s2[n++] = P7_KEY(aa, bb); }
        s3[0] = P7_KEY(7, 0); s3[1] = P7_KEY(7, 1);
#pragma unroll
        for (int aa = 8; aa < 16; ++aa) s3[aa - 6] = P7_KEY(aa, 0);
#pragma unroll
        for (int k = 10; k < 16; ++k) s3[k] = 0u;
        sort16_desc(s2); sort16_desc(s3);
        top16_desc(list, s2); top16_desc(list, s3);
#undef P7_KEY
        float vv[16]; float sum = 0.f;
        const float v0 = ord_val(list[0] & 0xFFFFFF00u);
#pragma unroll
        for (int k = 0; k < 16; ++k) { vv[k] = __expf(ord_val(list[k] & 0xFFFFFF00u) - v0); sum += vv[k]; }
        const float inv = 1.0f / sum;
        const size_t obase = (size_t)(tok0 + fr) * 128 + (4 * quad + q) * 16;
#pragma unroll
        for (int k = 0; k < 16; ++k) {
            const unsigned pos = 255u - (list[k] & 255u), aa = pos >> 4, bb = pos & 15u;
            const unsigned i1 = 127u - (tlw[aa] & 127u), i2 = 127u - (tlw[16 + bb] & 127u);
            const unsigned e = i1 * 128u + i2;
            EIDX[obase + k] = (unsigned short)e;
            EG[obase + k] = vv[k] * inv * ESU[e];
            ESDT[obase + k] = ESD[e];
        }
    }
}

__device__ __forceinline__ int dot16(const u32x4 a, const u32x4 b) {
    int s = __builtin_amdgcn_sdot4((int)a.x, (int)b.x, 0, false);
    s = __builtin_amdgcn_sdot4((int)a.y, (int)b.y, s, false);
    s = __builtin_amdgcn_sdot4((int)a.z, (int)b.z, s, false);
    s = __builtin_amdgcn_sdot4((int)a.w, (int)b.w, s, false);
    return s;
}
typedef float f32x2 __attribute__((ext_vector_type(2)));
__device__ __forceinline__ void up_fma2(f32x2 (&acc)[8], const u32x4 u, float c) {
    const f32x2 cc = {c, c};
    acc[0] += cc * (f32x2){(float)(u.x & 0xffu), (float)((u.x >> 8) & 0xffu)}; acc[1] += cc * (f32x2){(float)((u.x >> 16) & 0xffu), (float)(u.x >> 24)};
    acc[2] += cc * (f32x2){(float)(u.y & 0xffu), (float)((u.y >> 8) & 0xffu)}; acc[3] += cc * (f32x2){(float)((u.y >> 16) & 0xffu), (float)(u.y >> 24)};
    acc[4] += cc * (f32x2){(float)(u.z & 0xffu), (float)((u.z >> 8) & 0xffu)}; acc[5] += cc * (f32x2){(float)((u.z >> 16) & 0xffu), (float)(u.z >> 24)};
    acc[6] += cc * (f32x2){(float)(u.w & 0xffu), (float)((u.w >> 8) & 0xffu)}; acc[7] += cc * (f32x2){(float)((u.w >> 16) & 0xffu), (float)(u.w >> 24)};
}
struct SliceJob { int slice, rank, nloc; };
__device__ __forceinline__ void p8_load_e(unsigned (&e)[8], const unsigned short* __restrict__ EIDX, int tok, int g) {
    const u32x4 t0 = *(const u32x4*)(EIDX + (size_t)tok * 128 + g * 16), t1 = *(const u32x4*)(EIDX + (size_t)tok * 128 + g * 16 + 8);
    e[0] = t0.x; e[1] = t0.y; e[2] = t0.z; e[3] = t0.w; e[4] = t1.x; e[5] = t1.y; e[6] = t1.z; e[7] = t1.w;
}
#define P8_EID(e, s) (((s) & 1) ? ((e)[(s) >> 1] >> 16) : ((e)[(s) >> 1] & 0xffffu))
typedef int i32x4 __attribute__((ext_vector_type(4)));
__device__ __forceinline__ void phase8a(const Args& a, LAS unsigned char* lds, int tid, const SliceJob jb_) {
    unsigned char* ws = a.ws;
    const SliceJob jb{__builtin_amdgcn_readfirstlane(jb_.slice), __builtin_amdgcn_readfirstlane(jb_.rank), __builtin_amdgcn_readfirstlane(jb_.nloc)};
    const unsigned char* EDT = ws + WS_EDOWN + (size_t)jb.slice * 16384 * 128;
    const bf16* XB = (const bf16*)(ws + WS_H) + jb.slice * 256;
    int* P = (int*)(ws + WS_PPART) + (size_t)jb.slice * NTOK * 128;
    const int lane = tid & 63, w = __builtin_amdgcn_readfirstlane(tid >> 6), g = lane >> 3, i = lane & 7, st = jb.nloc * 8;
    LAS unsigned char* scr = lds + w * 1024;
    LAS unsigned char* red = lds + 8192 + w * 4608 + g * 544 + i * 4;
    LAS unsigned char* redr = lds + 8192 + w * 4608 + g * 544 + i * 64;
    float gq[4];
    { const f32x4 nf = *(const f32x4*)((const float*)a.in[I_NORM_FFN] + jb.slice * 256 + 4 * lane); const float k = 119.0f / *(const float*)(ws + WS_GMAX); gq[0] = nf[0] * k; gq[1] = nf[1] * k; gq[2] = nf[2] * k; gq[3] = nf[3] * k; }
    const unsigned char* abase = lane < 32 ? ws + WS_EIDX + lane * 8 : ws + WS_AMAX;
    const unsigned astride = lane < 32 ? 256u : 4u;
#define P8A_AUX(ax, tok) ax = *(const u32x2*)(abase + (size_t)(unsigned)(tok) * astride);
#define P8A_GATHER(d, hx, am, ax, tok) { *(LAS u32x2*)(scr + lane * 8) = ax; \
        asm volatile("s_waitcnt lgkmcnt(0)" ::: "memory"); \
        unsigned e[8]; { const u32x4 t0 = *(const LAS u32x4*)(scr + g * 32), t1 = *(const LAS u32x4*)(scr + g * 32 + 16); e[0] = t0.x; e[1] = t0.y; e[2] = t0.z; e[3] = t0.w; e[4] = t1.x; e[5] = t1.y; e[6] = t1.z; e[7] = t1.w; } \
        am = *(const LAS float*)(scr + 256); \
        _Pragma("unroll") for (int j = 0; j < 16; ++j) d[j] = *(const u32x4*)(EDT + (unsigned)(P8_EID(e, j) * 128u + i * 16)); \
        hx = *(const u32x2*)(XB + (size_t)(tok) * D + 4 * lane); }
#define P8A_STEP(d, hx, am, ax, tok) { const int tk = tok; u32x4 hA, hB; { const float ia = 1.0f / fmaxf(am, 1e-30f); \
            const int g0 = (int)rintf(__uint_as_float(hx.x << 16) * gq[0] * ia), g1 = (int)rintf(__uint_as_float(hx.x & 0xffff0000u) * gq[1] * ia); \
            const int g2 = (int)rintf(__uint_as_float(hx.y << 16) * gq[2] * ia), g3 = (int)rintf(__uint_as_float(hx.y & 0xffff0000u) * gq[3] * ia); \
              \
            const int h0 = min(max(g0, -119), 119), h1 = min(max(g1, -119), 119), h2 = min(max(g2, -119), 119), h3 = min(max(g3, -119), 119); \
            const int a0 = (h0 + 8) >> 4, a1 = (h1 + 8) >> 4, a2 = (h2 + 8) >> 4, a3 = (h3 + 8) >> 4; \
            const unsigned A16 = (unsigned)(a0 & 15) | ((unsigned)(a1 & 15) << 4) | ((unsigned)(a2 & 15) << 8) | ((unsigned)(a3 & 15) << 12); \
            const unsigned B16 = (unsigned)((h0 - 16 * a0) & 15) | ((unsigned)((h1 - 16 * a1) & 15) << 4) | ((unsigned)((h2 - 16 * a2) & 15) << 8) | ((unsigned)((h3 - 16 * a3) & 15) << 12); \
            *(LAS unsigned short*)(scr + 512 + g * 32 + 2 * i) = (unsigned short)A16; *(LAS unsigned short*)(scr + 512 + g * 32 + 16 + 2 * i) = (unsigned short)B16; \
            asm volatile("s_waitcnt lgkmcnt(0)" ::: "memory");     \
            hA = *(const LAS u32x4*)(scr + 512 + i * 32); hB = *(const LAS u32x4*)(scr + 512 + i * 32 + 16); } \
        int v[16]; _Pragma("unroll") for (int j = 0; j < 16; ++j) { int sa = 0, sb = 0; \
            _Pragma("unroll") for (int p = 0; p < 4; ++p) { sa = __builtin_amdgcn_sdot8((int)d[j][p], (int)hA[p], sa, false); sb = __builtin_amdgcn_sdot8((int)d[j][p], (int)hB[p], sb, false); } \
            v[j] = sa * 16 + sb; } \
        P8A_GATHER(d, hx, am, ax, min(tk + 2 * st, NTOK - 1)) P8A_AUX(ax, min(tk + 4 * st, NTOK - 1)) \
          \
        _Pragma("unroll") for (int j = 0; j < 16; ++j) *(LAS int*)(red + j * 32) = v[j]; \
        int v2[2]; { const i32x4 q0 = *(const LAS i32x4*)(redr), q1 = *(const LAS i32x4*)(redr + 16), q2 = *(const LAS i32x4*)(redr + 32), q3 = *(const LAS i32x4*)(redr + 48); \
            const i32x4 s0 = q0 + q1, s1 = q2 + q3; v2[0] = (s0[0] + s0[1]) + (s0[2] + s0[3]); v2[1] = (s1[0] + s1[1]) + (s1[2] + s1[3]); } \
        u32x2 o; o.x = (unsigned)v2[0]; o.y = (unsigned)v2[1]; *(u32x2*)(P + (size_t)tk * 128 + g * 16 + 2 * i) = o; }
    int tokA = jb.rank * 8 + w, tokB = tokA + st;
    if (tokA >= NTOK) return;
    u32x4 dA[16], dB[16]; u32x2 hxA, hxB, axA, axB; float amA, amB;
    P8A_AUX(axA, tokA)
    P8A_AUX(axB, min(tokB, NTOK - 1))
    P8A_GATHER(dA, hxA, amA, axA, tokA)
    P8A_AUX(axA, min(tokA + 2 * st, NTOK - 1))
    P8A_GATHER(dB, hxB, amB, axB, min(tokB, NTOK - 1))
    P8A_AUX(axB, min(tokB + 2 * st, NTOK - 1))
    for (int np = ((NTOK - 1 - tokA) / st + 2) >> 1; np > 0; --np) {
        P8A_STEP(dA, hxA, amA, axA, min(tokA, NTOK - 1))
        P8A_STEP(dB, hxB, amB, axB, min(tokB, NTOK - 1))
        tokA += 2 * st; tokB += 2 * st;
    }
#undef P8A_AUX
#undef P8A_GATHER
#undef P8A_STEP
}
__device__ __forceinline__ void phase8b(const Args& a, int tid) {
    unsigned char* ws = a.ws;
    const int* P = (const int*)(ws + WS_PPART); const float* EG = (const float*)(ws + WS_EGATE); const float* ESDT = (const float*)(ws + WS_ESDT);
    const float* R2 = (const float*)(ws + WS_R2); const float* AMAX = (const float*)(ws + WS_AMAX); float* CSC = (float*)(ws + WS_CSC); unsigned char* CQ = ws + WS_COEFQ;
    const float gmax127 = *(const float*)(ws + WS_GMAX) * (1.0f / 119.0f);
    const int lane = tid & 63, stp = gridDim.x * 8;
    int tok = blockIdx.x * 8 + (tid >> 6);
    if (tok >= NTOK) return;
    typedef int i32x2_t __attribute__((ext_vector_type(2)));
    i32x2_t p[4], np[4]; f32x2 eg, sd, neg, nsd; float am, r2, nam, nr2;
#define P8B_LOAD(p, eg, sd, am, r2, t) { _Pragma("unroll") for (int x = 0; x < 4; ++x) p[x] = *(const i32x2_t*)(P + ((size_t)x * NTOK + (t)) * 128 + 2 * lane); \
        eg = *(const f32x2*)(EG + (size_t)(t) * 128 + 2 * lane); sd = *(const f32x2*)(ESDT + (size_t)(t) * 128 + 2 * lane); am = AMAX[t]; r2 = R2[t]; }
    P8B_LOAD(p, eg, sd, am, r2, tok)
    for (; tok < NTOK; tok += stp) {
        const int tn = min(tok + stp, NTOK - 1);
        P8B_LOAD(np, neg, nsd, nam, nr2, tn)
        const i32x2_t sm = (p[0] + p[1]) + (p[2] + p[3]);
        const float sh = am * r2 * gmax127;
        const float c0 = eg.x * gelu_erf((float)sm.x * sh * sd.x), c1 = eg.y * gelu_erf((float)sm.y * sh * sd.y);
        float cm = fmaxf(fabsf(c0), fabsf(c1));
#pragma unroll
        for (int x = 1; x < 64; x <<= 1) cm = fmaxf(cm, __shfl_xor(cm, x));
        cm = fmaxf(cm, 1e-30f);
        const float qi = 127.0f / cm;
        const int q0 = (int)rintf(c0 * qi), q1 = (int)rintf(c1 * qi);
        { const int r0 = 64 * ((lane >> 2) & 1) + 16 * (lane & 3) + (lane >> 3); CQ[(size_t)tok * 128 + r0] = (unsigned char)q0; CQ[(size_t)tok * 128 + r0 + 8] = (unsigned char)q1; }
        int qs = q0 + q1;
#pragma unroll
        for (int x = 1; x < 64; x <<= 1) qs += __shfl_xor(qs, x);
        if (lane == 0) { u32x2 o; o.x = __float_as_uint(cm * (1.0f / 127.0f)); o.y = (unsigned)qs; *(u32x2*)(CSC + 2 * (size_t)tok) = o; }
#pragma unroll
        for (int x = 0; x < 4; ++x) p[x] = np[x];
        eg = neg; sd = nsd; am = nam; r2 = nr2;
    }
#undef P8B_LOAD
}
typedef int v2i32_t __attribute__((ext_vector_type(2)));
typedef int i32x4 __attribute__((ext_vector_type(4)));
__device__ __forceinline__ void phase8c(const Args& a, LAS unsigned char* lds, int tid, const SliceJob jb_) {
    unsigned char* ws = a.ws;
    const SliceJob jb{__builtin_amdgcn_readfirstlane(jb_.slice), __builtin_amdgcn_readfirstlane(jb_.rank), __builtin_amdgcn_readfirstlane(jb_.nloc)};
    const unsigned char* EUT = ws + WS_EUP + (size_t)jb.slice * 16384 * 128;
    const bf16* XBs = (const bf16*)(ws + WS_H) + jb.slice * 256; bf16* X2 = (bf16*)(ws + WS_MIXED);
    const int lane = tid & 63, w = __builtin_amdgcn_readfirstlane(tid >> 6), g = lane >> 3, i = lane & 7, fr = lane & 15, q = lane >> 4, st = jb.nloc * 8;
    LAS unsigned char* img = lds + w * 16384;
    LAS unsigned char* scr = lds + 131072 + w * 2048;
    LAS unsigned char* rbase = img + (16 * q + (fr >> 1)) * 128 + 8 * (fr & 1);
    const int F = ((fr >> 2) & 3) | ((q & 1) << 2);
    const unsigned sc0 = 16u * (unsigned)(i ^ ((g >> 1) & 3)), sc1 = sc0 ^ 64u;
    const unsigned rbase32 = (unsigned)(__UINTPTR_TYPE__)rbase, img32 = (unsigned)(__UINTPTR_TYPE__)img, scr32 = (unsigned)(__UINTPTR_TYPE__)scr;
    const unsigned char* bbase = lane < 32 ? ws + WS_COEFQ + lane * 4 : ws + WS_CSC + 4 * min(lane - 32, 1);
    const unsigned bstride = lane < 32 ? 128u : 8u, l4 = (unsigned)lane * 4u;
    const i32x4 NIB = (i32x4){0x0f0f0f0f, 0x0f0f0f0f, 0x0f0f0f0f, 0x0f0f0f0f};
#define P8C_AUXDMA(par, tok) { const unsigned char* s_ = ws + WS_EIDX + (size_t)(unsigned)(tok) * 256u; const unsigned char* p_ = bbase + (size_t)(unsigned)(tok) * bstride; \
        asm volatile("s_mov_b32 m0, %0\n\ts_nop 0\n\tglobal_load_lds_dword %1, %2" :: "s"(scr32 + (unsigned)(par) * 1024u), "v"(l4), "s"(s_) : "memory"); \
        asm volatile("s_mov_b32 m0, %0\n\ts_nop 0\n\tglobal_load_lds_dword %1, off" :: "s"(scr32 + (unsigned)(par) * 1024u + 256u), "v"(p_) : "memory"); }
#define P8C_XDMA(par, tok) { const unsigned char* s_ = (const unsigned char*)(XBs + (size_t)(tok) * D); \
        asm volatile("s_mov_b32 m0, %0\n\ts_nop 0\n\tglobal_load_lds_dword %1, %2" :: "s"(scr32 + (unsigned)(par) * 1024u + 512u), "v"(l4), "s"(s_) : "memory"); \
        asm volatile("s_mov_b32 m0, %0\n\ts_nop 0\n\tglobal_load_lds_dword %1, %2" :: "s"(scr32 + (unsigned)(par) * 1024u + 768u), "v"(l4), "s"(s_ + 256) : "memory"); }
#define P8C_SPREAD(e, c0, c1, cs, cz, par) { LAS unsigned char* ab = scr + (par) * 1024; \
        { const u32x4 t0 = *(const LAS u32x4*)(ab + g * 32), t1 = *(const LAS u32x4*)(ab + g * 32 + 16); e[0] = t0.x; e[1] = t0.y; e[2] = t0.z; e[3] = t0.w; e[4] = t1.x; e[5] = t1.y; e[6] = t1.z; e[7] = t1.w; } \
        c0 = *(const LAS i32x4*)(ab + 256 + 16 * q); c1 = *(const LAS i32x4*)(ab + 320 + 16 * q); cs = *(const LAS float*)(ab + 384); cz = *(const LAS int*)(ab + 388); }
#define P8C_DMA(h, e) { _Pragma("unroll") for (int jj = 0; jj < 8; ++jj) \
        asm volatile("s_mov_b32 m0, %0\n\ts_nop 0\n\tglobal_load_lds_dwordx4 %1, %2" :: "s"(img32 + (unsigned)((h) * 8192 + jj * 1024)), "v"((unsigned)(P8_EID(e, 8 * (h) + jj) * 128u + (((jj >> 1) & 1) ? sc1 : sc0))), "s"(EUT) : "memory"); }
#define P8C_RD(h, t, x0, x1) { const unsigned rb = rbase32 + 16u * (unsigned)((t) ^ F); \
        asm volatile("ds_read_b64_tr_b8 %0, %1 offset:%2" : "=v"(x0) : "v"(rb), "i"((h) * 8192)); asm volatile("ds_read_b64_tr_b8 %0, %1 offset:%2" : "=v"(x1) : "v"(rb), "i"((h) * 8192 + 1024)); }
#define P8C_WT(n, x0, x1) asm volatile("s_waitcnt lgkmcnt(" #n ")" : "+v"(x0), "+v"(x1));
#define P8C_MM(h, t, kk, x0, x1) { const i32x4 wv = (i32x4){x0[0], x0[1], x1[0], x1[1]}; \
        aL[t] = __builtin_amdgcn_mfma_i32_16x16x64_i8(kk, wv & NIB, (h) ? aL[t] : (i32x4){0, 0, 0, 0}, 0, 0, 0); aR[t] = __builtin_amdgcn_mfma_i32_16x16x64_i8(kk, wv, (h) ? aR[t] : (i32x4){0, 0, 0, 0}, 0, 0, 0); }
#define P8C_HALF(h, kk) { v2i32_t pa0, pa1, pb0, pb1, pc0, pc1; \
        P8C_RD(h, 0, pa0, pa1) P8C_RD(h, 1, pb0, pb1) \
        P8C_RD(h, 2, pc0, pc1) P8C_WT(4, pa0, pa1) P8C_MM(h, 0, kk, pa0, pa1) \
        P8C_RD(h, 3, pa0, pa1) P8C_WT(4, pb0, pb1) P8C_MM(h, 1, kk, pb0, pb1) \
        P8C_RD(h, 4, pb0, pb1) P8C_WT(4, pc0, pc1) P8C_MM(h, 2, kk, pc0, pc1) \
        P8C_RD(h, 5, pc0, pc1) P8C_WT(4, pa0, pa1) P8C_MM(h, 3, kk, pa0, pa1) \
        P8C_RD(h, 6, pa0, pa1) P8C_WT(4, pb0, pb1) P8C_MM(h, 4, kk, pb0, pb1) \
        P8C_RD(h, 7, pb0, pb1) P8C_WT(4, pc0, pc1) P8C_MM(h, 5, kk, pc0, pc1) \
        P8C_WT(2, pa0, pa1) P8C_MM(h, 6, kk, pa0, pa1) P8C_WT(0, pb0, pb1) P8C_MM(h, 7, kk, pb0, pb1) }
    int tok = jb.rank * 8 + w;
    if (tok >= NTOK) return;
    __builtin_amdgcn_s_waitcnt(0x0F70);
    unsigned e[8]; i32x4 c0, c1; float cs; int cz;
    P8C_AUXDMA(0, tok)
    asm volatile("s_waitcnt vmcnt(0)" ::: "memory");
    P8C_SPREAD(e, c0, c1, cs, cz, 0)
    asm volatile("" ::: "memory");
    P8C_XDMA(0, tok)
    P8C_AUXDMA(1, min(tok + st, NTOK - 1))
    P8C_DMA(0, e) P8C_DMA(1, e)
    int par = 0;
    for (int n = (NTOK - 1 - tok) / st + 1; n > 0; --n) {
        asm volatile("s_waitcnt vmcnt(8)" ::: "memory");
        const i32x4 k0 = c0, k1 = c1; const float ks = cs; const int kz = 8 * cz;
        i32x4 aL[8], aR[8];
        P8C_HALF(0, k0)
        P8C_SPREAD(e, c0, c1, cs, cz, par ^ 1)
        asm volatile("s_waitcnt lgkmcnt(0)" ::: "memory");
        P8C_AUXDMA(par, min(tok + 2 * st, NTOK - 1))
        P8C_XDMA(par ^ 1, min(tok + st, NTOK - 1))
        P8C_DMA(0, e)
        asm volatile("s_waitcnt vmcnt(12)" ::: "memory");
        P8C_HALF(1, k1)
        int r0 = aL[0][0], r1 = aR[0][0], r2 = aL[1][0], r3 = aR[1][0];
#pragma unroll
        for (int p = 1; p < 4; ++p) { r0 = (q == p) ? aL[2 * p][0] : r0; r1 = (q == p) ? aR[2 * p][0] : r1; r2 = (q == p) ? aL[2 * p + 1][0] : r2; r3 = (q == p) ? aR[2 * p + 1][0] : r3; }
        *(LAS v2i32_t*)(img + 8192 + (64 * q + 2 * fr) * 4) = (v2i32_t){r0, r1}; *(LAS v2i32_t*)(img + 8192 + (64 * q + 32 + 2 * fr) * 4) = (v2i32_t){r2, r3};
        asm volatile("s_waitcnt lgkmcnt(0)" ::: "memory");
        const i32x4 rr = *(const LAS i32x4*)(img + 8192 + lane * 16);
        const u32x2 yy = *(const LAS u32x2*)(scr + par * 1024 + 512 + lane * 8);
        { u32x2 o; o.x = pk2(__uint_as_float(yy.x << 16) + (float)(rr[0] - kz) * ks, __uint_as_float(yy.x & 0xffff0000u) + (float)((rr[1] - rr[0]) >> 4) * ks);
          o.y = pk2(__uint_as_float(yy.y << 16) + (float)(rr[2] - kz) * ks, __uint_as_float(yy.y & 0xffff0000u) + (float)((rr[3] - rr[2]) >> 4) * ks);
          bf16* p_ = X2 + (size_t)tok * D + jb.slice * 256 + 4 * lane; asm volatile("global_store_dwordx2 %0, %1, off" :: "v"(p_), "v"(o) : "memory"); }
        P8C_DMA(1, e)
        tok += st; par ^= 1;
    }
    asm volatile("s_waitcnt vmcnt(0)" ::: "memory");
#undef P8C_AUXDMA
#undef P8C_XDMA
#undef P8C_SPREAD
#undef P8C_DMA
#undef P8C_RD
#undef P8C_WT
#undef P8C_MM
#undef P8C_HALF
}
__device__ __forceinline__ void phase8d(const Args& a, int tid) {
    const float* NF = (const float*)a.in[I_NORM_F]; const bf16* X2 = (const bf16*)(a.ws + WS_MIXED);
    const int lane = tid & 63, stp = gridDim.x * 8;
    int tok = blockIdx.x * 8 + (tid >> 6);
    if (tok >= NTOK) return;
    u32x2 v[4], nx[4]; f32x4 nf[4];
#pragma unroll
    for (int j = 0; j < 4; ++j) { v[j] = *(const u32x2*)(X2 + (size_t)tok * D + (lane + 64 * j) * 4); nf[j] = *(const f32x4*)(NF + (lane + 64 * j) * 4); }
    for (; tok < NTOK; tok += stp) {
        const bf16* nrow = X2 + (size_t)min(tok + stp, NTOK - 1) * D;
#pragma unroll
        for (int j = 0; j < 4; ++j) nx[j] = *(const u32x2*)(nrow + (lane + 64 * j) * 4);
        float* row = a.out + (size_t)tok * D; float ss = 0.f; f32x4 f[4];
#pragma unroll
        for (int j = 0; j < 4; ++j) { f[j] = (f32x4){__uint_as_float(v[j].x << 16), __uint_as_float(v[j].x & 0xffff0000u), __uint_as_float(v[j].y << 16), __uint_as_float(v[j].y & 0xffff0000u)};
            ss += (f[j][0] * f[j][0] + f[j][1] * f[j][1]) + (f[j][2] * f[j][2] + f[j][3] * f[j][3]); }
        const float r = rsqrtf(wave_sum(ss) * (1.0f / D) + RMS_EPS);
#pragma unroll
        for (int j = 0; j < 4; ++j) *(f32x4*)(row + (lane + 64 * j) * 4) = f[j] * r * nf[j];
#pragma unroll
        for (int j = 0; j < 4; ++j) v[j] = nx[j];
    }
}

__device__ __forceinline__ int opaque(int v) { asm volatile("" : "+v"(v)); return v; }
__global__ void __launch_bounds__(512, 2) fwd(Args args) {
    extern __shared__ __attribute__((aligned(16))) unsigned char lds_raw[];
    LAS unsigned char* lds = (LAS unsigned char*)lds_raw;
    const int tid = threadIdx.x;
    if (tid < 4) ((LAS unsigned*)(lds + LDS_BARW))[tid] = 0u;
    __syncthreads();
    unsigned* barw = (unsigned*)(args.ws + WS_CTL);
    const unsigned my_xcc = xb_xcc_id();
    if (tid == 0) ((LAS int*)(lds + LDS_JOB))[3] = (MK_N_LAUNCHES == 1) ? (int)xb_add(&barw[CW_RANK + 64 * my_xcc], 1u) : 0;
    XcdBarrier bar; bar.bar = barw; bar.x = 0; bar.st = nullptr;
    const int lo = args.ph_lo, hi = args.ph_hi;
    if (MK_N_LAUNCHES == 1 || hi - lo > 1) bar = xcd_barrier_post(barw, (volatile LAS unsigned*)(lds + LDS_BARW));
#if MK_N_LAUNCHES == 1
#define IN(k) true
#else
#define IN(k) (lo <= (k) && (k) < hi)
#endif
#define SEAM(k) do { if (IN(k) && IN((k) + 1)) xcd_barrier(bar); } while (0)
    if (IN(0)) phase0(args, opaque(tid));
    SEAM(0);
    if (IN(1)) phase1(args, lds, opaque(tid));
    SEAM(1);
    if (IN(2)) phase2(args, lds, opaque(tid));
    SEAM(2);
    if (IN(3)) phase3(args, lds, opaque(tid));
    SEAM(3);
    if (IN(4)) phase4(args, lds, opaque(tid));
    SEAM(4);
    if (IN(5)) phase5(args, lds, opaque(tid));
    SEAM(5);
    if (IN(6)) phase6(args, lds, opaque(tid));
    SEAM(6);
    if (IN(7)) phase7(args, lds, opaque(tid));
    SEAM(7);
    SliceJob jb, jc;
    {
        LAS int* jw = (LAS int*)(lds + LDS_JOB);
        if (tid == 0) {
            int cnt[16]; bool ok8 = true;
#pragma unroll
            for (int j = 0; j < 16; ++j) { cnt[j] = (int)xb_ld(&barw[XB_XCNT(j)]); ok8 = ok8 && (j < 8 ? cnt[j] > 0 : cnt[j] == 0); }
            int mine = 0;
#pragma unroll
            for (int j = 0; j < 16; ++j) mine = (j == (int)my_xcc) ? cnt[j] : mine;
            const int my_rank = jw[3];
            int lower = 0, upper = 0;
#pragma unroll
            for (int j = 0; j < 16; ++j) { lower = (j == (int)(my_xcc & ~1u)) ? cnt[j] : lower; upper = (j == (int)(my_xcc | 1u)) ? cnt[j] : upper; }
            if (MK_N_LAUNCHES == 1 && ok8 && my_rank < mine) { jw[0] = (int)my_xcc; jw[1] = my_rank; jw[2] = mine;
                jw[4] = (int)(my_xcc >> 1); jw[5] = my_rank + ((my_xcc & 1u) ? lower : 0); jw[6] = lower + upper; }
            else { const int sl = blockIdx.x & 7, G = (int)gridDim.x; jw[0] = sl; jw[1] = blockIdx.x >> 3; jw[2] = (G + 7 - sl) >> 3;
                const int nlo = (G + 7 - (sl & ~1)) >> 3, nhi = (G + 7 - (sl | 1)) >> 3; jw[4] = sl >> 1; jw[5] = (blockIdx.x >> 3) + ((sl & 1) ? nlo : 0); jw[6] = nlo + nhi; }
        }
        __syncthreads();
        jb.slice = jw[0]; jb.rank = jw[1]; jb.nloc = jw[2]; jc.slice = jw[4]; jc.rank = jw[5]; jc.nloc = jw[6];
    }
    if (IN(8)) phase8a(args, lds, opaque(tid), jc);
    SEAM(8);
    if (IN(9)) phase8b(args, opaque(tid));
    SEAM(9);
    if (IN(10)) phase8c(args, lds, opaque(tid), jc);
    SEAM(10);
    if (IN(11)) phase8d(args, opaque(tid));
#undef IN
#undef SEAM
}

extern "C" void kernel_launch(void* const* d_in, const int* in_sizes, int n_in, void* d_out, int out_size, void* d_ws, size_t ws_size, hipStream_t stream) {
    static int grid = 0;
    if (grid == 0) {
        if (n_in != 19 || out_size != NTOK * D || ws_size < WS_END) {
            fprintf(stderr, "kernel_launch: unexpected shapes (n_in %d, out %d, ws %zu); nothing launched\n", n_in, out_size, ws_size); grid = -1; return; }
        int dev = 0, cus = 0;
        if (hipGetDevice(&dev) != hipSuccess || hipDeviceGetAttribute(&cus, hipDeviceAttributeMultiprocessorCount, dev) != hipSuccess) { grid = -1; return; }
        if (hipFuncSetAttribute((const void*)fwd, hipFuncAttributeMaxDynamicSharedMemorySize, LDS_BYTES) != hipSuccess) { fprintf(stderr, "kernel_launch: hipFuncSetAttribute failed\n"); grid = -1; return; }
        int per_cu = 0;
        if (hipOccupancyMaxActiveBlocksPerMultiprocessor(&per_cu, (const void*)fwd, 512, LDS_BYTES) != hipSuccess || per_cu < 1) { fprintf(stderr, "kernel_launch: occupancy query says %d blocks per CU\n", per_cu); (void)hipGetLastError(); }
        grid = cus;
    }
    if (grid < 0) return;
    (void)hipMemsetAsync((char*)d_ws + WS_CTL, 0, CTL_BYTES, stream);
    Args a{};
    for (int i = 0; i < 19; ++i) a.in[i] = d_in[i];
    a.out = (float*)d_out; a.ws = (unsigned char*)d_ws;
    if (MK_N_LAUNCHES == 1) {
        a.ph_lo = 0; a.ph_hi = NPHASE;
        hipLaunchKernelGGL(fwd, dim3(grid), dim3(512), LDS_BYTES, stream, a);
    } else {
        for (int p = 0; p < NPHASE; ++p) { a.ph_lo = p; a.ph_hi = p + 1; hipLaunchKernelGGL(fwd, dim3(grid), dim3(512), LDS_BYTES, stream, a); }
    }
}
```
